# Optimizing an MI355X kernel written in HIP

```python
import jax, jax.numpy as jnp
from jax import lax
import numpy as np

D_MODEL = 2048
BATCH = 4
SEQ = 2048
DEPTH = 2

CTX_LEN = 256
GRID_W = 64
N_MIXERS = 2
RET_HEADS = 8
RET_QK_DIM = D_MODEL // RET_HEADS
RET_V_DIM = 2 * D_MODEL // RET_HEADS
RET_CHUNK = 128
ATT_HEADS = 16
ATT_KV_HEADS = 4
ATT_HEAD_DIM = D_MODEL // ATT_HEADS
ATT_BLOCK = 128
FFN_DIM = 256 * ((8 * D_MODEL // 3 + 255) // 256)
CONV_WIDTH = 3
ROPE_THETA = 10000.0
EPS = 1e-6

kernel_name = 'hybrid_retention_gqa_dit'


def rms_norm(x, w):
    xf = x.astype(jnp.float32)
    y = xf * lax.rsqrt(jnp.mean(xf * xf, axis=-1, keepdims=True) + EPS)
    return (y * w.astype(jnp.float32)).astype(x.dtype)


def modulate(h, shift, scale):
    return h * (1.0 + scale) + shift


def axial_rope_tables(n, head_dim):
    rows = n // GRID_W
    row = jnp.repeat(jnp.arange(rows, dtype=jnp.float32), GRID_W)
    col = jnp.tile(jnp.arange(GRID_W, dtype=jnp.float32), rows)
    n_freq = head_dim // 4
    inv = ROPE_THETA ** (-jnp.arange(n_freq, dtype=jnp.float32) / n_freq)
    ang = jnp.concatenate([row[:, None] * inv, col[:, None] * inv], axis=-1)
    return jnp.cos(ang), jnp.sin(ang)


def apply_rope(x, cos, sin):
    xf = x.astype(jnp.float32).reshape(*x.shape[:-1], -1, 2)
    x1, x2 = xf[..., 0], xf[..., 1]
    c = cos[None, :, None, :]
    s = sin[None, :, None, :]
    out = jnp.stack([x1 * c - x2 * s, x1 * s + x2 * c], axis=-1).reshape(x.shape)
    return out.astype(x.dtype)


def retention_scan(q, k, v, log_gamma, state0):
    bsz, heads, length, _ = q.shape
    dv = v.shape[-1]
    n_chunks = length // RET_CHUNK
    idx = jnp.arange(RET_CHUNK, dtype=jnp.float32)
    lg = log_gamma[:, None]
    diff = idx[:, None] - idx[None, :]
    lower = diff >= 0
    intra = jnp.where(lower, jnp.exp(lg[:, :, None] * jnp.where(lower, diff, 0.0)), 0.0)
    q_decay = jnp.exp(lg * (idx + 1.0))[:, :, None]
    k_decay = jnp.exp(lg * (RET_CHUNK - 1.0 - idx))[:, :, None]
    chunk_decay = jnp.exp(log_gamma * RET_CHUNK)[:, None, None]

    def to_chunks(t):
        return jnp.moveaxis(t.reshape(bsz, heads, n_chunks, RET_CHUNK, t.shape[-1]), 2, 0)

    def step(state, qkv):
        qc, kc, vc = qkv
        scores = jnp.einsum('bhnd,bhmd->bhnm', qc, kc) * intra
        out = jnp.einsum('bhnm,bhme->bhne', scores, vc) + jnp.einsum('bhnd,bhde->bhne', qc, state) * q_decay
        state = state * chunk_decay + jnp.einsum('bhmd,bhme->bhde', kc * k_decay, vc)
        return state, out

    state, out = lax.scan(step, state0, (to_chunks(q), to_chunks(k), to_chunks(v)))
    out = jnp.moveaxis(out, 0, 2).reshape(bsz, heads, length, dv)
    return out, state


def retention_mixer(hx, hc, w_in, w_out, log_decay, gn_w, cos, sin, need_ctx):
    d = D_MODEL

    def project(h):
        bsz, length = h.shape[:2]
        q, k, v, g = jnp.split(h @ w_in, [d, 2 * d, 4 * d], axis=-1)
        q = q.reshape(bsz, length, RET_HEADS, RET_QK_DIM)
        k = k.reshape(bsz, length, RET_HEADS, RET_QK_DIM) * (RET_QK_DIM ** -0.5)
        v = v.reshape(bsz, length, RET_HEADS, RET_V_DIM)
        return q, k, v, g

    def to_heads(t):
        return jnp.swapaxes(t, 1, 2).astype(jnp.float32)

    def flip(t):
        return t[:, :, ::-1]

    qx, kx, vx, gx = project(hx)
    qc, kc, vc, gc = project(hc)
    qx, kx = apply_rope(qx, cos, sin), apply_rope(kx, cos, sin)
    qx, kx, vx = to_heads(qx), to_heads(kx), to_heads(vx)
    qc, kc, vc = to_heads(qc), to_heads(kc), to_heads(vc)
    log_gamma = -jnp.exp(log_decay.astype(jnp.float32))
    zeros = jnp.zeros((hx.shape[0], RET_HEADS, RET_QK_DIM, RET_V_DIM), jnp.float32)
    oc_f, st_f = retention_scan(qc, kc, vc, log_gamma[0], zeros)
    oc_b, st_b = retention_scan(flip(qc), flip(kc), flip(vc), log_gamma[1], zeros)
    ox_f, _ = retention_scan(qx, kx, vx, log_gamma[0], st_f)
    ox_b, _ = retention_scan(flip(qx), flip(kx), flip(vx), log_gamma[1], st_b)

    def finish(y, g, dtype):
        bsz, _, length, _ = y.shape
        mu = jnp.mean(y, axis=-1, keepdims=True)
        var = jnp.mean(jnp.square(y - mu), axis=-1, keepdims=True)
        y = (y - mu) * lax.rsqrt(var + EPS)
        y = jnp.swapaxes(y, 1, 2).reshape(bsz, length, RET_HEADS * RET_V_DIM) * gn_w.astype(jnp.float32)
        return (jax.nn.silu(g.astype(jnp.float32)) * y).astype(dtype) @ w_out

    out_x = finish(ox_f + flip(ox_b), gx, hx.dtype)
    out_c = finish(oc_f + flip(oc_b), gc, hc.dtype) if need_ctx else None
    return out_x, out_c


def attend(q, k, v):
    bsz, lq = q.shape[:2]
    groups = ATT_HEADS // ATT_KV_HEADS
    n_blocks = lq // ATT_BLOCK
    qb = jnp.moveaxis(q.reshape(bsz, n_blocks, ATT_BLOCK, ATT_KV_HEADS, groups, ATT_HEAD_DIM), 1, 0)
    scale = ATT_HEAD_DIM ** -0.5

    def block(qi):
        s = jnp.einsum('bqkgd,btkd->bkgqt', qi, k).astype(jnp.float32) * scale
        p = jax.nn.softmax(s, axis=-1).astype(v.dtype)
        return jnp.einsum('bkgqt,btkd->bqkgd', p, v)

    o = lax.map(block, qb)
    return jnp.moveaxis(o, 0, 1).reshape(bsz, lq, ATT_HEADS * ATT_HEAD_DIM)


def gqa_mixer(hx, hc, w_in, w_out, q_norm, k_norm, cos, sin, need_ctx):
    q_w = ATT_HEADS * ATT_HEAD_DIM
    kv_w = ATT_KV_HEADS * ATT_HEAD_DIM

    def project(h):
        bsz, length = h.shape[:2]
        q, k, v = jnp.split(h @ w_in, [q_w, q_w + kv_w], axis=-1)
        q = rms_norm(q.reshape(bsz, length, ATT_HEADS, ATT_HEAD_DIM), q_norm)
        k = rms_norm(k.reshape(bsz, length, ATT_KV_HEADS, ATT_HEAD_DIM), k_norm)
        v = v.reshape(bsz, length, ATT_KV_HEADS, ATT_HEAD_DIM)
        return q, k, v

    qx, kx, vx = project(hx)
    qc, kc, vc = project(hc)
    qx, kx = apply_rope(qx, cos, sin), apply_rope(kx, cos, sin)
    k_all = jnp.concatenate([kc, kx], axis=1)
    v_all = jnp.concatenate([vc, vx], axis=1)
    out_x = attend(qx, k_all, v_all) @ w_out
    out_c = attend(qc, kc, vc) @ w_out if need_ctx else None
    return out_x, out_c


def conv_ffn(h, w_up, conv_w, conv_b, w_down):
    length = h.shape[1]
    u = h @ w_up
    pad = CONV_WIDTH // 2
    up = jnp.pad(u, ((0, 0), (pad, pad), (0, 0)))
    u = sum(up[:, j:j + length] * conv_w[j] for j in range(CONV_WIDTH)) + conv_b
    a, b = jnp.split(u, 2, axis=-1)
    return (jax.nn.silu(a) * b) @ w_down


def setup_inputs(seed: int = 0) -> dict:
    key = jax.random.key(seed)
    ks = jax.random.split(key, 24)
    d = D_MODEL
    n_ret = (DEPTH + 1) // 2
    n_att = DEPTH // 2
    f32 = jnp.float32

    def nrm(k, shape, scale):
        return jax.random.normal(k, shape, f32) * scale

    decay_rate = jnp.exp2(-5.0 - jnp.arange(RET_HEADS, dtype=f32))
    base_log_decay = jnp.log(-jnp.log1p(-decay_rate))
    att_in = (ATT_HEADS + 2 * ATT_KV_HEADS) * ATT_HEAD_DIM
    return {
        'x': nrm(ks[0], (BATCH, SEQ, d), 1.0),
        'c': nrm(ks[1], (BATCH, d), 1.0),
        'ctx': nrm(ks[2], (BATCH, CTX_LEN, d), 1.0),
        'c_ctx': nrm(ks[3], (d,), 1.0),
        'ada_w': nrm(ks[4], (DEPTH, d, 6 * d), d ** -0.5),
        'ada_b': nrm(ks[5], (DEPTH, 6 * d), 0.02),
        'norm_w': 1.0 + nrm(ks[6], (DEPTH, 2, d), 0.02),
        'ret_w_in': nrm(ks[7], (n_ret, d, 6 * d), d ** -0.5),
        'ret_w_out': nrm(ks[8], (n_ret, 2 * d, d), (2 * d) ** -0.5),
        'ret_log_decay': base_log_decay[None, None, :] + nrm(ks[9], (n_ret, 2, RET_HEADS), 0.1),
        'ret_gn_w': 1.0 + nrm(ks[10], (n_ret, 2 * d), 0.02),
        'attn_w_in': nrm(ks[11], (n_att, d, att_in), d ** -0.5),
        'attn_w_out': nrm(ks[12], (n_att, d, d), d ** -0.5),
        'attn_q_norm': 1.0 + nrm(ks[13], (n_att, ATT_HEAD_DIM), 0.02),
        'attn_k_norm': 1.0 + nrm(ks[14], (n_att, ATT_HEAD_DIM), 0.02),
        'ffn_w_up': nrm(ks[15], (DEPTH, d, 2 * FFN_DIM), d ** -0.5),
        'ffn_conv_w': nrm(ks[16], (DEPTH, CONV_WIDTH, 2 * FFN_DIM), CONV_WIDTH ** -0.5),
        'ffn_conv_b': nrm(ks[17], (DEPTH, 2 * FFN_DIM), 0.02),
        'ffn_w_down': nrm(ks[18], (DEPTH, FFN_DIM, d), FFN_DIM ** -0.5),
        'final_norm_w': 1.0 + nrm(ks[19], (d,), 0.02),
    }


def reference(x, c, ctx, c_ctx, ada_w, ada_b, norm_w, ret_w_in, ret_w_out, ret_log_decay, ret_gn_w,
              attn_w_in, attn_w_out, attn_q_norm, attn_k_norm, ffn_w_up, ffn_conv_w, ffn_conv_b,
              ffn_w_down, final_norm_w):
    n_tok = x.shape[1]
    cos_r, sin_r = axial_rope_tables(n_tok, RET_QK_DIM)
    cos_a, sin_a = axial_rope_tables(n_tok, ATT_HEAD_DIM)
    c_act = jax.nn.silu(c)
    cc_act = jax.nn.silu(c_ctx)
    for i in range(DEPTH):
        last = i == DEPTH - 1
        j = i // N_MIXERS
        mod_x = (c_act @ ada_w[i] + ada_b[i])[:, None, :]
        mod_c = cc_act @ ada_w[i] + ada_b[i]
        sh1x, sc1x, g1x, sh2x, sc2x, g2x = jnp.split(mod_x, 6, axis=-1)
        sh1c, sc1c, g1c, sh2c, sc2c, g2c = jnp.split(mod_c, 6, axis=-1)
        hx = modulate(rms_norm(x, norm_w[i, 0]), sh1x, sc1x)
        hc = modulate(rms_norm(ctx, norm_w[i, 0]), sh1c, sc1c)
        if i % N_MIXERS == 0:
            ox, oc = retention_mixer(hx, hc, ret_w_in[j], ret_w_out[j], ret_log_decay[j], ret_gn_w[j],
                                     cos_r, sin_r, not last)
        else:
            ox, oc = gqa_mixer(hx, hc, attn_w_in[j], attn_w_out[j], attn_q_norm[j], attn_k_norm[j],
                               cos_a, sin_a, not last)
        x = x + g1x * ox
        hx = modulate(rms_norm(x, norm_w[i, 1]), sh2x, sc2x)
        x = x + g2x * conv_ffn(hx, ffn_w_up[i], ffn_conv_w[i], ffn_conv_b[i], ffn_w_down[i])
        if not last:
            ctx = ctx + g1c * oc
            hc = modulate(rms_norm(ctx, norm_w[i, 1]), sh2c, sc2c)
            ctx = ctx + g2c * conv_ffn(hc, ffn_w_up[i], ffn_conv_w[i], ffn_conv_b[i], ffn_w_down[i])
    return rms_norm(x, final_norm_w)
```

```cpp
#include <hip/hip_runtime.h>
#include <hip/hip_bf16.h>
#include <hip/hip_cooperative_groups.h>
#include <cstdio>
#include <cstdint>
#include <cmath>
#include <type_traits>
namespace cg = cooperative_groups;
#ifndef ONE_LAUNCH
#define ONE_LAUNCH 1
#endif
namespace pg8 {
#define PG8_LAS __attribute__((address_space(3)))
typedef unsigned short bf16_t;
typedef short bf16x8 __attribute__((ext_vector_type(8)));
typedef float f32x4 __attribute__((ext_vector_type(4)));
typedef unsigned u32x4 __attribute__((ext_vector_type(4)));
constexpr int BM = 256, BK = 64, HALF = 128, HTB = HALF * BK * 2  , STAGE_BYTES = 8 * HTB, NXCD = 8, WGM = 8;

__host__ __device__ __forceinline__ int lds_byte(int r, int c) { const int st = (r >> 4) * 2 + (c >> 5), rr = r & 15, cc = c & 31, ob = rr * 64 + cc * 2; return st * 1024 + (ob ^ (((ob >> 9) & 1) << 5)); }
__host__ __device__ __forceinline__ void stage_rc(int b, int& R, int& C) { const int st = b / 1024, sb = b % 1024, swz = sb ^ (((sb >> 9) & 1) << 5); R = (st >> 1) * 16 + swz / 64; C = (st & 1) * 32 + (swz % 64) / 2; }
__host__ __device__ __forceinline__ int perm32(int rho) { const int n = rho >> 4, i = rho & 15; return 8 * (i >> 2) + 4 * n + (i & 3); }

struct Unit { int pm, pn; };
struct Gemm { const bf16_t* A; const bf16_t* Bt; int M, N, K; };

struct StaticOrder {
    int nM, nN, nwg, G, c;
    __host__ __device__ void init(int M, int N, int G_, int c_) { nM = M / BM; nN = N / BM; nwg = nM * nN; G = G_; c = c_; }
    __host__ __device__ bool next(int i, Unit& u) const {
        const long L = (long)i * G + c; if (L >= nwg) return false;
        int wgid = (int)L; { const int q = nwg / NXCD, r = nwg % NXCD, xcd = wgid % NXCD, off = wgid / NXCD; wgid = (xcd < r ? xcd * (q + 1) : r * (q + 1) + (xcd - r) * q) + off; }
        const int nig = WGM * nN, gid = wgid / nig, fm = gid * WGM, gsz = (nM - fm) < WGM ? (nM - fm) : WGM;
        u.pm = fm + ((wgid % nig) % gsz); u.pn = (wgid % nig) / gsz; return true;
    }
    __device__ __forceinline__ void a_ready(const Unit&) const {}
    __device__ __forceinline__ void done(const Unit&) const {}
};

__device__ __forceinline__ unsigned cvt_pk_bf16(float lo, float hi) { unsigned r; asm volatile("v_cvt_pk_bf16_f32 %0, %1, %2" : "=v"(r) : "v"(lo), "v"(hi)); return r; }
typedef float f32x2 __attribute__((ext_vector_type(2)));
template <class F> struct EpiRow8 {
    static constexpr bool PERM = true, AFTER_DRAIN = false; F f;
    __device__ __forceinline__ void operator()(const f32x4 (&acc)[2][2][4][2], const Unit& u, int wr, int wc, int fr, int fq) const {
        const int row0 = u.pm * BM + wr * 64 + fr, col0 = u.pn * BM + wc * 32 + 8 * fq;
#pragma unroll
        for (int ai = 0; ai < 2; ++ai)
#pragma unroll
            for (int m = 0; m < 4; ++m)
#pragma unroll
                for (int bj = 0; bj < 2; ++bj) f.apply(row0 + ai * HALF + m * 16, col0 + bj * HALF, acc[ai][bj][m][0], acc[ai][bj][m][1]);
    }
};
__device__ __forceinline__ u32x4 pack8(const f32x4 a, const f32x4 b) { u32x4 w; w.x = cvt_pk_bf16(a[0], a[1]); w.y = cvt_pk_bf16(a[2], a[3]); w.z = cvt_pk_bf16(b[0], b[1]); w.w = cvt_pk_bf16(b[2], b[3]); return w; }
struct FPlain {
    bf16_t* O; int ldc;
    __device__ __forceinline__ void apply(int row, int col, f32x4 v0, f32x4 v1) const { *(u32x4*)(O + (size_t)row * ldc + col) = pack8(v0, v1); }
};
struct FRope {
    bf16_t *Q, *K, *V, *G; const float* cosr; const float* sinr; int ML;
    __device__ __forceinline__ void apply(int row, int col, f32x4 v0, f32x4 v1) const {
        if (col < 4096) {
            const bool isk = col >= 2048; const int c = col & 2047;
            if (isk) { v0 = v0 * 0.0625f; v1 = v1 * 0.0625f; }
            if (row < ML) {
                const int t = row & 2047, pi = (c & 255) >> 1;
                const f32x4 cs = *(const f32x4*)(cosr + t * 128 + pi), sn = *(const f32x4*)(sinr + t * 128 + pi);
                f32x4 a, b;
                a[0] = v0[0] * cs[0] - v0[1] * sn[0]; a[1] = v0[0] * sn[0] + v0[1] * cs[0];
                a[2] = v0[2] * cs[1] - v0[3] * sn[1]; a[3] = v0[2] * sn[1] + v0[3] * cs[1];
                b[0] = v1[0] * cs[2] - v1[1] * sn[2]; b[1] = v1[0] * sn[2] + v1[1] * cs[2];
                b[2] = v1[2] * cs[3] - v1[3] * sn[3]; b[3] = v1[2] * sn[3] + v1[3] * cs[3];
                v0 = a; v1 = b;
            }
            *(u32x4*)((isk ? K : Q) + (size_t)row * 2048 + c) = pack8(v0, v1);
        } else if (col < 8192) { *(u32x4*)(V + (size_t)row * 4096 + (col - 4096)) = pack8(v0, v1); }
        else { *(u32x4*)(G + (size_t)row * 4096 + (col - 8192)) = pack8(v0, v1); }
    }
};
struct FRes {
    const float* baseX; const float* baseC; float* XS; const float* gate; int ML;
    __device__ __forceinline__ void apply(int row, int col, f32x4 v0, f32x4 v1) const {
        const int mr = row < ML ? (row >> 11) : 4;
        const float* b = (row < ML ? baseX + (size_t)row * 2048 : baseC + (size_t)(row - ML) * 2048) + col;
        const float* gp = gate + mr * 12288 + col;
        const f32x4 b0 = *(const f32x4*)b, b1 = *(const f32x4*)(b + 4), g0 = *(const f32x4*)gp, g1 = *(const f32x4*)(gp + 4);
        float* o = XS + (size_t)row * 2048 + col;
        *(f32x4*)o = b0 + g0 * v0; *(f32x4*)(o + 4) = b1 + g1 * v1;
    }
};
template <class Epi, class Sched, bool ALIGN_EPI = false, bool SP2 = false>
__device__ __forceinline__ void gemm_phase(PG8_LAS unsigned char* lds, const Gemm g, const Sched& S, const Epi& E, const int tid) {
    const int wid = __builtin_amdgcn_readfirstlane(tid >> 6), lane = tid & 63, wr = wid >> 2, wc = wid & 3, fr = lane & 15, fq = lane >> 4;
    const int K = g.K, nt = K / BK;
    unsigned voffA[2], voffB[2];
#pragma unroll
    for (int i = 0; i < 2; ++i) { int R, C; stage_rc(tid * 16 + i * 8192, R, C); const int Rb = Epi::PERM ? ((R & ~31) + perm32(R & 31)) : R;
        voffA[i] = (unsigned)(R * K + C) * 2u; voffB[i] = (unsigned)(Rb * K + C) * 2u; }
    const size_t kstep = (size_t)(BK * 2);
    const size_t hstep = (size_t)HALF * K * 2;
    const size_t tstep = 2 * hstep;
    const unsigned ldsw = (unsigned)wid * 1024u;
    const int aoff = lds_byte(wr * 64 + fr, fq * 8), boff = lds_byte(wc * 32 + fr, fq * 8);
#define PG8_SA(b, h) (((b) * 2 + (h)) * HTB)
#define PG8_SB(b, h) ((4 + (b) * 2 + (h)) * HTB)
#define PG8_STAGE(bufoff, gbase, voff) do { _Pragma("unroll") for (int _i = 0; _i < 2; ++_i) \
        __builtin_amdgcn_global_load_lds((const unsigned*)((const char*)(gbase) + (voff)[_i]), (PG8_LAS unsigned*)(lds + (bufoff) + ldsw + _i * 8192), 16, 0, 0); } while (0)
#define PG8_LDA(dst, b, h) do { _Pragma("unroll") for (int m = 0; m < 4; ++m) _Pragma("unroll") for (int k = 0; k < 2; ++k) dst[m][k] = *(const PG8_LAS bf16x8*)(lds + PG8_SA(b, h) + aoff + m * 2048 + k * 1024); } while (0)
#define PG8_LDB(dst, b, h) do { _Pragma("unroll") for (int n = 0; n < 2; ++n) _Pragma("unroll") for (int k = 0; k < 2; ++k) dst[n][k] = *(const PG8_LAS bf16x8*)(lds + PG8_SB(b, h) + boff + n * 2048 + k * 1024); } while (0)
#define PG8_MMA(ai, bj, At, Bt) do { __builtin_amdgcn_s_setprio(1); _Pragma("unroll") for (int m = 0; m < 4; ++m) _Pragma("unroll") for (int n = 0; n < 2; ++n) _Pragma("unroll") for (int k = 0; k < 2; ++k) \
        acc[ai][bj][m][n] = __builtin_amdgcn_mfma_f32_16x16x32_bf16(Bt[n][k], At[m][k], acc[ai][bj][m][n], 0, 0, 0); __builtin_amdgcn_s_setprio(0); } while (0)
#define PG8_WAIT_V(n) asm volatile("s_waitcnt vmcnt(" #n ")" ::: "memory")
#define PG8_WAIT_L(n) asm volatile("s_waitcnt lgkmcnt(" #n ")" ::: "memory")
#define PG8_BAR __builtin_amdgcn_s_barrier()
#define PG8_SCHED __builtin_amdgcn_sched_barrier(0)
    Unit cur, nxt; int ui = 0;
    if (!S.next(0, cur)) return;
    f32x4 acc[2][2][4][2];
#pragma unroll
    for (int a = 0; a < 2; ++a)
#pragma unroll
        for (int b = 0; b < 2; ++b)
#pragma unroll
            for (int m = 0; m < 4; ++m)
#pragma unroll
                for (int n = 0; n < 2; ++n) acc[a][b][m][n] = (f32x4){0.f, 0.f, 0.f, 0.f};
    bf16x8 At[4][2], B0[2][2], B1[2][2];
    const char* cA = (const char*)g.A + (size_t)cur.pm * tstep; const char* cB = (const char*)g.Bt + (size_t)cur.pn * tstep;
    S.a_ready(cur);
    if constexpr (SP2) {
        PG8_STAGE(PG8_SB(0, 0), cB, voffB); PG8_STAGE(PG8_SB(0, 1), cB + hstep, voffB); PG8_STAGE(PG8_SA(0, 0), cA, voffA); PG8_STAGE(PG8_SA(0, 1), cA + hstep, voffA);
        if (wr == 1) PG8_BAR;
        PG8_WAIT_V(2); PG8_BAR;
        PG8_STAGE(PG8_SB(1, 0), cB + kstep, voffB); PG8_STAGE(PG8_SA(1, 0), cA + kstep, voffA); PG8_STAGE(PG8_SB(1, 1), cB + hstep + kstep, voffB);
        PG8_WAIT_V(6); PG8_BAR;
    } else {
        PG8_STAGE(PG8_SB(0, 0), cB, voffB); PG8_STAGE(PG8_SA(0, 0), cA, voffA); PG8_STAGE(PG8_SB(0, 1), cB + hstep, voffB); PG8_STAGE(PG8_SA(0, 1), cA + hstep, voffA);
        if (wr == 1) PG8_BAR;
        PG8_WAIT_V(4); PG8_BAR;
        PG8_STAGE(PG8_SB(1, 0), cB + kstep, voffB); PG8_STAGE(PG8_SA(1, 0), cA + kstep, voffA); PG8_STAGE(PG8_SB(1, 1), cB + hstep + kstep, voffB);
        PG8_WAIT_V(6); PG8_BAR;
    }
    for (;;) {
        const bool has_next = S.next(ui + 1, nxt);
        const char* nA = has_next ? (const char*)g.A + (size_t)nxt.pm * tstep : cA; const char* nB = has_next ? (const char*)g.Bt + (size_t)nxt.pn * tstep : cB;
        for (int t = 0; t < nt; t += 2) {
            const bool last = (t == nt - 2);
            const char* a1 = cA + (size_t)(t + 1) * kstep;
            const char* a2 = last ? nA : cA + (size_t)(t + 2) * kstep; const char* b2 = last ? nB : cB + (size_t)(t + 2) * kstep;
            const char* a3 = a2 + kstep; const char* b3 = b2 + kstep;
            if (last && has_next) S.a_ready(nxt);
            if constexpr (SP2) {
            PG8_LDB(B0, 0, 0); PG8_LDB(B1, 0, 1); PG8_SCHED; PG8_LDA(At, 0, 0); PG8_STAGE(PG8_SA(1, 1), a1 + hstep, voffA);
            PG8_WAIT_V(8); PG8_WAIT_L(0); PG8_BAR; PG8_MMA(0, 0, At, B0); PG8_MMA(0, 1, At, B1); PG8_BAR; PG8_SCHED;
            PG8_LDA(At, 0, 1); PG8_STAGE(PG8_SB(0, 0), b2, voffB); PG8_STAGE(PG8_SB(0, 1), b2 + hstep, voffB); PG8_STAGE(PG8_SA(0, 0), a2, voffA);
            PG8_WAIT_V(8); PG8_WAIT_L(0); PG8_BAR; PG8_MMA(1, 0, At, B0); PG8_MMA(1, 1, At, B1); PG8_BAR; PG8_SCHED;
            PG8_LDB(B0, 1, 0); PG8_LDB(B1, 1, 1); PG8_SCHED; PG8_LDA(At, 1, 0); PG8_STAGE(PG8_SA(0, 1), a2 + hstep, voffA);
            PG8_WAIT_V(8); PG8_WAIT_L(0); PG8_BAR; PG8_MMA(0, 0, At, B0); PG8_MMA(0, 1, At, B1); PG8_BAR; PG8_SCHED;
            PG8_LDA(At, 1, 1); PG8_STAGE(PG8_SB(1, 0), b3, voffB); PG8_STAGE(PG8_SB(1, 1), b3 + hstep, voffB); PG8_STAGE(PG8_SA(1, 0), a3, voffA);
            PG8_WAIT_V(8); PG8_WAIT_L(0); PG8_BAR; PG8_MMA(1, 0, At, B0); PG8_MMA(1, 1, At, B1); PG8_BAR; PG8_SCHED;
            } else {
            PG8_LDB(B0, 0, 0); PG8_SCHED; PG8_LDA(At, 0, 0); PG8_STAGE(PG8_SA(1, 1), a1 + hstep, voffA);
            PG8_WAIT_L(8); PG8_BAR; PG8_WAIT_L(0); PG8_MMA(0, 0, At, B0); PG8_BAR; PG8_SCHED;
            PG8_LDB(B1, 0, 1); PG8_STAGE(PG8_SB(0, 0), b2, voffB);
            PG8_BAR; PG8_WAIT_L(0); PG8_MMA(0, 1, At, B1); PG8_BAR;
            PG8_LDA(At, 0, 1); PG8_STAGE(PG8_SA(0, 0), a2, voffA);
            PG8_BAR; PG8_WAIT_L(0); PG8_MMA(1, 0, At, B0); PG8_BAR; PG8_SCHED;
            PG8_STAGE(PG8_SB(0, 1), b2 + hstep, voffB);
            PG8_WAIT_V(6); PG8_BAR; PG8_MMA(1, 1, At, B1); PG8_BAR;
            PG8_LDB(B0, 1, 0); PG8_SCHED; PG8_LDA(At, 1, 0); PG8_STAGE(PG8_SA(0, 1), a2 + hstep, voffA);
            PG8_WAIT_L(8); PG8_BAR; PG8_WAIT_L(0); PG8_MMA(0, 0, At, B0); PG8_BAR; PG8_SCHED;
            PG8_LDB(B1, 1, 1); PG8_STAGE(PG8_SB(1, 0), b3, voffB);
            PG8_BAR; PG8_WAIT_L(0); PG8_MMA(0, 1, At, B1); PG8_BAR;
            PG8_LDA(At, 1, 1); PG8_STAGE(PG8_SA(1, 0), a3, voffA);
            PG8_BAR; PG8_WAIT_L(0); PG8_MMA(1, 0, At, B0); PG8_BAR; PG8_SCHED;
            PG8_STAGE(PG8_SB(1, 1), b3 + hstep, voffB);
            PG8_WAIT_V(6); PG8_BAR; PG8_MMA(1, 1, At, B1); PG8_BAR;
            }
        }
        if constexpr (ALIGN_EPI) { if (wr == 0) PG8_BAR; }
        if constexpr (!Epi::AFTER_DRAIN) { E(acc, cur, wr, wc, fr, fq); S.done(cur); }
        if (!has_next) break;
#pragma unroll
        for (int a = 0; a < 2; ++a)
#pragma unroll
            for (int b = 0; b < 2; ++b)
#pragma unroll
                for (int m = 0; m < 4; ++m)
#pragma unroll
                    for (int n = 0; n < 2; ++n) acc[a][b][m][n] = (f32x4){0.f, 0.f, 0.f, 0.f};
        cur = nxt; cA = nA; cB = nB; ++ui;
        if constexpr (ALIGN_EPI) { if (wr == 1) PG8_BAR; }
    }
    PG8_WAIT_V(0);
    if constexpr (!ALIGN_EPI) { if (wr == 0) PG8_BAR; }
    PG8_BAR;
    if constexpr (Epi::AFTER_DRAIN) { E.fused(acc, cur, wr, wc, fr, fq, lds, wid, lane); S.done(cur); }
#undef PG8_SA
#undef PG8_SB
#undef PG8_STAGE
#undef PG8_LDA
#undef PG8_LDB
#undef PG8_MMA
#undef PG8_WAIT_V
#undef PG8_WAIT_L
#undef PG8_BAR
#undef PG8_SCHED
}
}

namespace att {
using bf16 = __hip_bfloat16;
constexpr int D = 128, NW = 8, QBLK = 32, KVBLK = 64;
constexpr float SCALE = 0.088388347648318440f;
constexpr float THR = 8.f;
constexpr int LDQ = 2048, LDK = 512, LDO = 2048;
constexpr size_t SHM_V = KVBLK * D * 2, SHM_K = KVBLK * D * 2, SHM_ATTN = 2 * SHM_V + 2 * SHM_K + NW * 64 * 4;
using bf16x8 = __attribute__((ext_vector_type(8))) short;
using s16x4  = __attribute__((ext_vector_type(4))) short;
using f32x16 = __attribute__((ext_vector_type(16))) float;
using u32x4  = __attribute__((ext_vector_type(4))) unsigned;
#define KSWZ(row, colB) ((row) * 256 + ((colB) ^ (((row) & 7) << 4)))
#define SBAR() __builtin_amdgcn_sched_barrier(0)
__device__ __forceinline__ int crow(int r, int hi) { return (r & 3) + 8 * (r >> 2) + 4 * hi; }
__device__ __forceinline__ unsigned cvtpk(float lo, float hi) { unsigned r; asm volatile("v_cvt_pk_bf16_f32 %0, %1, %2" : "=v"(r) : "v"(lo), "v"(hi)); return r; }
__device__ __forceinline__ void partialSM(f32x16& p0, f32x16& p1, float& m_reg, float& mn, float& alpha) {
  constexpr float C = SCALE * 1.4426950408889634f;
  float pmax = p0[0]; for (int r = 1; r < 16; ++r) pmax = fmaxf(pmax, p0[r]); for (int r = 0; r < 16; ++r) pmax = fmaxf(pmax, p1[r]);
  { auto rr = __builtin_amdgcn_permlane32_swap(__float_as_uint(pmax), __float_as_uint(pmax), false, false);
    pmax = fmaxf(__uint_as_float(rr[0]), __uint_as_float(rr[1])); }
  if (__builtin_expect(__all(pmax - m_reg <= THR / SCALE), 1)) { mn = m_reg; alpha = 1.f; }
  else { mn = fmaxf(m_reg, pmax); alpha = __builtin_amdgcn_exp2f((m_reg - mn) * C); m_reg = mn; }
  float mnC = -mn * C;
  for (int r = 0; r < 16; ++r) p0[r] = fmaf(p0[r], C, mnC); for (int r = 0; r < 16; ++r) p1[r] = fmaf(p1[r], C, mnC);
  for (int r = 0; r < 16; ++r) p0[r] = __builtin_amdgcn_exp2f(p0[r]);
}
__device__ __forceinline__ void finishSM(f32x16& p0, f32x16& p1, float alpha, float& l_reg, bf16x8& pa0, bf16x8& pa1, bf16x8& pa2, bf16x8& pa3) {
  for (int r = 0; r < 16; ++r) p1[r] = __builtin_amdgcn_exp2f(p1[r]);
  float ps = 0; for (int r = 0; r < 16; ++r) ps += p0[r]; for (int r = 0; r < 16; ++r) ps += p1[r];
  { auto rr = __builtin_amdgcn_permlane32_swap(__float_as_uint(ps), __float_as_uint(ps), false, false);
    ps = __uint_as_float(rr[0]) + __uint_as_float(rr[1]); }
  l_reg = l_reg * alpha + ps;
#define PK4(P, BASE, OUT) do { unsigned a0 = cvtpk(P[BASE + 0], P[BASE + 1]), a1 = cvtpk(P[BASE + 2], P[BASE + 3]);   \
    unsigned b0 = cvtpk(P[BASE + 4], P[BASE + 5]), b1 = cvtpk(P[BASE + 6], P[BASE + 7]);                              \
    auto r0 = __builtin_amdgcn_permlane32_swap(a0, b0, false, false); auto r1 = __builtin_amdgcn_permlane32_swap(a1, b1, false, false); \
    u32x4 w = {r0[0], r1[0], r0[1], r1[1]}; OUT = *reinterpret_cast<bf16x8*>(&w); } while (0)
  PK4(p0, 0, pa0); PK4(p0, 8, pa1); PK4(p1, 0, pa2); PK4(p1, 8, pa3);
#undef PK4
}
__device__ __forceinline__ void qkt(f32x16& p0, f32x16& p1, const bf16* Ks, const bf16x8* qr, int r32, int hi) {
  p0 = f32x16{}; p1 = f32x16{};
  for (int d0 = 0; d0 < 8; ++d0) { int cb = (d0 * 16 + hi * 8) * 2;
    bf16x8 b0 = *reinterpret_cast<const bf16x8*>((const char*)Ks + KSWZ(r32, cb));
    bf16x8 b1 = *reinterpret_cast<const bf16x8*>((const char*)Ks + KSWZ(32 + r32, cb));
    p0 = __builtin_amdgcn_mfma_f32_32x32x16_bf16(b0, qr[d0], p0, 0, 0, 0);
    p1 = __builtin_amdgcn_mfma_f32_32x32x16_bf16(b1, qr[d0], p1, 0, 0, 0); }
}
__device__ __forceinline__ int v_st(int k, int c) { const int kk = (k & ~0xC) | ((k & 4) << 1) | ((k & 8) >> 1); return ((kk >> 3) * 4 + (c >> 5)) * 512 + ((kk & 7) * 32 + (c & 31)) * 2; }
__device__ __forceinline__ int v_rd_base(int lane) { return ((lane & 3) << 3) | (((lane >> 2) & 3) << 6) | (((lane >> 4) & 1) << 5) | (((lane >> 5) & 1) << 8); }
constexpr int v_rd_off(int d0, int ks, int half) { return d0 * 512 + ks * 4096 + half * 2048; }
template <int OFF> __device__ __forceinline__ s16x4 tr_read(int vb) {
  s16x4 r; asm volatile("ds_read_b64_tr_b16 %0, %1 offset:%2" : "=&v"(r) : "v"(vb), "i"(OFF) : "memory"); return r;
}
template <int D0> __device__ __forceinline__ void pv_one(f32x16& od, int vb, bf16x8 pa0, bf16x8 pa1, bf16x8 pa2, bf16x8 pa3) {
  const s16x4 l0 = tr_read<v_rd_off(D0, 0, 0)>(vb), h0 = tr_read<v_rd_off(D0, 0, 1)>(vb), l1 = tr_read<v_rd_off(D0, 1, 0)>(vb), h1 = tr_read<v_rd_off(D0, 1, 1)>(vb);
  const s16x4 l2 = tr_read<v_rd_off(D0, 2, 0)>(vb), h2 = tr_read<v_rd_off(D0, 2, 1)>(vb), l3 = tr_read<v_rd_off(D0, 3, 0)>(vb), h3 = tr_read<v_rd_off(D0, 3, 1)>(vb);
  asm volatile("s_waitcnt lgkmcnt(0)" ::: "memory"); SBAR();
#define PK(L, H) (bf16x8){L[0], L[1], L[2], L[3], H[0], H[1], H[2], H[3]}
  od = __builtin_amdgcn_mfma_f32_32x32x16_bf16(pa0, PK(l0, h0), od, 0, 0, 0);
  od = __builtin_amdgcn_mfma_f32_32x32x16_bf16(pa1, PK(l1, h1), od, 0, 0, 0);
  od = __builtin_amdgcn_mfma_f32_32x32x16_bf16(pa2, PK(l2, h2), od, 0, 0, 0);
  od = __builtin_amdgcn_mfma_f32_32x32x16_bf16(pa3, PK(l3, h3), od, 0, 0, 0);
#undef PK
}
__device__ __forceinline__ void pv_d0(f32x16* o, int vb, bf16x8 pa0, bf16x8 pa1, bf16x8 pa2, bf16x8 pa3) {
  pv_one<0>(o[0], vb, pa0, pa1, pa2, pa3); pv_one<1>(o[1], vb, pa0, pa1, pa2, pa3); pv_one<2>(o[2], vb, pa0, pa1, pa2, pa3); pv_one<3>(o[3], vb, pa0, pa1, pa2, pa3);
}
__device__ __forceinline__ void attn_dense_body(const bf16* __restrict__ Qb, const bf16* __restrict__ Kh, const bf16* __restrict__ Vh,
                                                bf16* __restrict__ Ob, int seq, char* lds, const int tid) {
  const int wid = tid >> 6, lane = tid & 63, r32 = lane & 31, hi = lane >> 5;
  bf16* V_lds = (bf16*)lds; bf16* K_lds = (bf16*)(lds + 2 * SHM_V);
  float* ws = (float*)(lds + 2 * SHM_V + 2 * SHM_K) + wid * 64; float* li_l = ws; float* al_l = ws + 32;
  float m_reg = -1e30f, l_reg = 0; f32x16 o[4] = {}; bf16x8 qr[8];
  const bf16* Qw = Qb + (long)(wid * QBLK + r32) * LDQ + hi * 8;
#pragma unroll
  for (int d0 = 0; d0 < 8; ++d0) qr[d0] = *reinterpret_cast<const bf16x8*>(Qw + d0 * 16);
  const int sr = tid >> 4, sc = (tid & 15) * 8, vst0 = v_st(sr, sc), vst1 = v_st(32 + sr, sc);
  const int vb0 = (int)(uintptr_t)V_lds + v_rd_base(lane);
  struct { bf16x8 vs0, vs1, ks0, ks1; } sr_[2];
#define SLOAD(i, k0) do { sr_[i].vs0 = *reinterpret_cast<const bf16x8*>(&Vh[(long)((k0) + sr) * LDK + sc]); sr_[i].vs1 = *reinterpret_cast<const bf16x8*>(&Vh[(long)((k0) + 32 + sr) * LDK + sc]); \
    sr_[i].ks0 = *reinterpret_cast<const bf16x8*>(&Kh[(long)((k0) + sr) * LDK + sc]); sr_[i].ks1 = *reinterpret_cast<const bf16x8*>(&Kh[(long)((k0) + 32 + sr) * LDK + sc]); } while (0)
#define SWRITE(b, i) do { *(bf16x8*)((char*)V_lds + (b) * SHM_V + vst0) = sr_[i].vs0;          \
    *(bf16x8*)((char*)V_lds + (b) * SHM_V + vst1) = sr_[i].vs1; int kc = sc * 2;               \
    *(bf16x8*)((char*)K_lds + (b) * SHM_K + KSWZ(sr, kc)) = sr_[i].ks0;                       \
    *(bf16x8*)((char*)K_lds + (b) * SHM_K + KSWZ(32 + sr, kc)) = sr_[i].ks1; } while (0)
#define SWAIT() do { asm volatile("s_waitcnt vmcnt(4)" ::: "memory"); } while (0)
#define RESC(a) do { if (__any((a) < 1.f)) { if (hi == 0) al_l[r32] = (a); asm volatile("s_waitcnt lgkmcnt(0)" ::: "memory"); \
    for (int d = 0; d < 4; ++d) for (int r = 0; r < 16; ++r) o[d][r] *= al_l[crow(r, hi)]; } } while (0)
  f32x16 pA0, pA1, pB0, pB1; float mnA, mnB, alA, alB; bf16x8 pa0, pa1, pa2, pa3; const int NT = seq / KVBLK;
  constexpr int SE = 0, SO = 1;
  SLOAD(SE, 0); asm volatile("s_waitcnt vmcnt(0)" ::: "memory"); SWRITE(0, SE); __syncthreads();
  qkt(pA0, pA1, K_lds, qr, r32, hi); partialSM(pA0, pA1, m_reg, mnA, alA);
  SLOAD(SO, KVBLK); { if (2 < NT) SLOAD(SE, 2 * KVBLK); }
  SWAIT(); SWRITE(1, SO); __syncthreads();
  for (int j = 1; j + 1 < NT; j += 2) {
    SBAR(); qkt(pB0, pB1, (bf16*)((char*)K_lds + SHM_K), qr, r32, hi);
    finishSM(pA0, pA1, alA, l_reg, pa0, pa1, pa2, pa3); SBAR();
    SLOAD(SO, (j + 2) * KVBLK); SBAR();
    pv_d0(o, vb0, pa0, pa1, pa2, pa3); partialSM(pB0, pB1, m_reg, mnB, alB);
    __syncthreads(); SWAIT(); SWRITE(0, SE);
    RESC(alB); __syncthreads();
    SBAR(); qkt(pA0, pA1, K_lds, qr, r32, hi);
    finishSM(pB0, pB1, alB, l_reg, pa0, pa1, pa2, pa3); SBAR();
    if (j + 3 < NT) SLOAD(SE, (j + 3) * KVBLK); SBAR();
    pv_d0(o, vb0 + (int)SHM_V, pa0, pa1, pa2, pa3); partialSM(pA0, pA1, m_reg, mnA, alA);
    __syncthreads(); SWAIT(); SWRITE(1, SO);
    RESC(alA); __syncthreads();
  }
  SBAR(); qkt(pB0, pB1, (bf16*)((char*)K_lds + SHM_K), qr, r32, hi);
  finishSM(pA0, pA1, alA, l_reg, pa0, pa1, pa2, pa3); SBAR();
  pv_d0(o, vb0, pa0, pa1, pa2, pa3); partialSM(pB0, pB1, m_reg, mnB, alB);
  __syncthreads(); RESC(alB);
  finishSM(pB0, pB1, alB, l_reg, pa0, pa1, pa2, pa3); SBAR();
  pv_d0(o, vb0 + (int)SHM_V, pa0, pa1, pa2, pa3);
  if (hi == 0) li_l[r32] = l_reg; asm volatile("s_waitcnt lgkmcnt(0)" ::: "memory");
  float rli[16];
#pragma unroll
  for (int r = 0; r < 16; ++r) rli[r] = __builtin_amdgcn_rcpf(li_l[crow(r, hi)]);
  bf16* Ow = Ob + (long)(wid * QBLK) * LDO;
#pragma unroll
  for (int r = 0; r < 16; ++r) { int orow = crow(r, hi);
    for (int d0 = 0; d0 < 4; ++d0) Ow[(long)orow * LDO + d0 * 32 + r32] = __float2bfloat16(o[d0][r] * rli[r]); }
#undef SLOAD
#undef SWRITE
#undef SWAIT
#undef RESC
}
}

typedef unsigned short bf16_t;
typedef short bf16x8 __attribute__((ext_vector_type(8)));
typedef short s16x4 __attribute__((ext_vector_type(4)));
typedef float f32x4 __attribute__((ext_vector_type(4)));
typedef unsigned u32x4 __attribute__((ext_vector_type(4)));
typedef unsigned u32x2 __attribute__((ext_vector_type(2)));
#define LAS __attribute__((address_space(3)))

constexpr int DM = 2048, NBATCH = 4, SEQ = 2048, CTXL = 256, ML = NBATCH * SEQ, MC = NBATCH * CTXL, MT = ML + MC;
constexpr int FF = 5632, FF2 = 2 * FF, NRIN = 6 * DM, NAIN = 3072, SKV = CTXL + SEQ;
constexpr int NWAVES = 8, NTHR = 512;
constexpr int LDS_BYTES = 144 * 1024;
constexpr float EPS = 1e-6f;

constexpr size_t al256(size_t x) { return (x + 255) / 256 * 256; }
constexpr size_t WS_CTL   = 0;
constexpr size_t WS_MOD   = 4096;
constexpr size_t WS_ROPER = WS_MOD + al256((size_t)2 * 5 * 12288 * 4);
constexpr size_t WS_ROPEA = WS_ROPER + (size_t)2 * 2048 * 128 * 4;
constexpr size_t WS_WRIN  = WS_ROPEA + (size_t)2 * 2048 * 64 * 4;
constexpr size_t WS_WROUT = WS_WRIN + (size_t)NRIN * DM * 2;
constexpr size_t WS_WAIN  = WS_WROUT + (size_t)DM * 2 * DM * 2;
constexpr size_t WS_WAOUT = WS_WAIN + (size_t)NAIN * DM * 2;
constexpr size_t WS_WUP   = WS_WAOUT + (size_t)DM * DM * 2;
constexpr size_t WS_WDN   = WS_WUP + (size_t)2 * FF2 * DM * 2;
constexpr size_t WS_XS    = WS_WDN + (size_t)2 * DM * FF * 2;
constexpr size_t WS_H     = WS_XS + (size_t)MT * DM * 4;
constexpr size_t WS_R1    = WS_H + (size_t)MT * DM * 2;
constexpr size_t R1_Q = 0, R1_K = (size_t)MT * DM * 2, R1_V = 2 * R1_K, R1_G = R1_V + (size_t)MT * 4096 * 2, R1_BYTES = R1_G + (size_t)MT * 4096 * 2;
constexpr size_t R1_QN = 0, R1_KN = (size_t)ML * DM * 2, R1_VN = R1_KN + (size_t)NBATCH * SKV * 512 * 2, R1_O = R1_VN + (size_t)NBATCH * SKV * 512 * 2;
constexpr size_t WS_R2    = WS_R1 + R1_BYTES;
constexpr size_t R2_BYTES = (size_t)2 * MT * 4096 * 2;
constexpr size_t WS_END   = WS_R2 + R2_BYTES;
static_assert((size_t)MT * FF2 * 2 <= R1_BYTES, "U fits region 1");
static_assert(R1_O + (size_t)ML * DM * 2 <= R1_BYTES, "layer-1 attention tensors fit region 1");

struct Args { const float* in[20]; float* out; unsigned char* ws; int ph_lo, ph_hi; };
enum { I_X = 0, I_C, I_CTX, I_CCTX, I_ADAW, I_ADAB, I_NORMW, I_RWIN, I_RWOUT, I_RLD, I_RGN, I_AWIN, I_AWOUT, I_AQN, I_AKN, I_FUP, I_FCW, I_FCB, I_FDN, I_FNW };
constexpr int NPH = 20;
#ifndef ONLY_PHASE
#define PHSEL(p) (p)
#else
#define PHSEL(p) ((p) == ONLY_PHASE ? ONLY_PHASE : -1)
#endif

__device__ __forceinline__ float wave_sum(float v) {
#pragma unroll
    for (int o = 1; o < 64; o <<= 1) v += __shfl_xor(v, o);
    return v;
}
__device__ __forceinline__ unsigned pk2(float lo, float hi) { unsigned r; asm volatile("v_cvt_pk_bf16_f32 %0, %1, %2" : "=v"(r) : "v"(lo), "v"(hi)); return r; }
__device__ __forceinline__ float bf2f(unsigned short h) { return __uint_as_float((unsigned)h << 16); }
__device__ __forceinline__ float silu_f(float x) { return x / (1.f + __expf(-x)); }
__device__ __forceinline__ void unpack8(const bf16x8 v, float* f) {
#pragma unroll
    for (int i = 0; i < 8; ++i) f[i] = bf2f((unsigned short)v[i]);
}
__device__ __forceinline__ u32x4 pack8f(const float* f) { u32x4 w; w.x = pk2(f[0], f[1]); w.y = pk2(f[2], f[3]); w.z = pk2(f[4], f[5]); w.w = pk2(f[6], f[7]); return w; }

__device__ __forceinline__ void transpose_item(const float* __restrict__ W, int K, int N, bf16_t* __restrict__ WT, LAS float* scr, int item, int lane) {
    const int nblk = N / 32, kb = item / nblk, nb = item % nblk, k0 = 64 * kb, n0 = 32 * nb;
#pragma unroll 8
    for (int i = 0; i < 32; ++i) { const int kk = 2 * i + (lane >> 5); scr[kk * 33 + (lane & 31)] = W[(size_t)(k0 + kk) * N + n0 + (lane & 31)]; }
    asm volatile("s_waitcnt lgkmcnt(0)" ::: "memory");
    const int c = lane & 7;
#pragma unroll
    for (int j = 0; j < 4; ++j) { const int n = (lane >> 3) + 8 * j; const LAS float* s = scr + (8 * c) * 33 + n;
        u32x4 o; o.x = pk2(s[0 * 33], s[1 * 33]); o.y = pk2(s[2 * 33], s[3 * 33]); o.z = pk2(s[4 * 33], s[5 * 33]); o.w = pk2(s[6 * 33], s[7 * 33]);
        *(u32x4*)(WT + (size_t)(n0 + n) * K + k0 + 8 * c) = o; }
    asm volatile("s_waitcnt lgkmcnt(0)" ::: "memory");
}
__device__ __forceinline__ void phase_prologue(const Args& a, unsigned char* ws, LAS unsigned char* lds, int bid, int G, int tid, int wave, int lane) {
    {
        LAS float* scr = (LAS float*)(lds + wave * 8448);
        const int gw = bid * NWAVES + wave, NGW = G * NWAVES;
        constexpr int I0 = (DM / 64) * (NRIN / 32), I1 = (2 * DM / 64) * (DM / 32), I2 = (DM / 64) * (NAIN / 32), I3 = (DM / 64) * (DM / 32), I4 = (DM / 64) * (FF2 / 32), I5 = (FF / 64) * (DM / 32);
        constexpr int NITEMS = I0 + I1 + I2 + I3 + 2 * I4 + 2 * I5;
        for (int it = gw; it < NITEMS; it += NGW) {
            int r = it;
            if (r < I0) { transpose_item(a.in[I_RWIN], DM, NRIN, (bf16_t*)(ws + WS_WRIN), scr, r, lane); continue; } r -= I0;
            if (r < I1) { transpose_item(a.in[I_RWOUT], 2 * DM, DM, (bf16_t*)(ws + WS_WROUT), scr, r, lane); continue; } r -= I1;
            if (r < I2) { transpose_item(a.in[I_AWIN], DM, NAIN, (bf16_t*)(ws + WS_WAIN), scr, r, lane); continue; } r -= I2;
            if (r < I3) { transpose_item(a.in[I_AWOUT], DM, DM, (bf16_t*)(ws + WS_WAOUT), scr, r, lane); continue; } r -= I3;
            if (r < 2 * I4) { const int l = r / I4; transpose_item(a.in[I_FUP] + (size_t)l * DM * FF2, DM, FF2, (bf16_t*)(ws + WS_WUP) + (size_t)l * FF2 * DM, scr, r - l * I4, lane); continue; } r -= 2 * I4;
            { const int l = r / I5; transpose_item(a.in[I_FDN] + (size_t)l * FF * DM, FF, DM, (bf16_t*)(ws + WS_WDN) + (size_t)l * DM * FF, scr, r - l * I5, lane); }
        }
    }
    __syncthreads();
    {
        LAS float* act = (LAS float*)lds;
        LAS float* red = (LAS float*)(lds + 40960);
        for (int i = tid; i < 5 * DM; i += NTHR) { const int r = i / DM, k = i % DM; const float v = r < 4 ? a.in[I_C][r * DM + k] : a.in[I_CCTX][k]; act[i] = silu_f(v); }
        __syncthreads();
        const int c4 = tid & 15, ks = tid >> 4;
        for (int it = bid; it < 2 * 192; it += G) {
            const int l = it / 192, c0 = (it % 192) * 64;
            f32x4 acc[5];
#pragma unroll
            for (int r = 0; r < 5; ++r) acc[r] = (f32x4){0.f, 0.f, 0.f, 0.f};
            const float* wp = a.in[I_ADAW] + (size_t)l * DM * 12288 + (size_t)(ks * 64) * 12288 + c0 + c4 * 4;
#pragma unroll 8
            for (int kk = 0; kk < 64; ++kk) { const f32x4 w = *(const f32x4*)(wp + (size_t)kk * 12288);
#pragma unroll
                for (int r = 0; r < 5; ++r) acc[r] += act[r * DM + ks * 64 + kk] * w; }
#pragma unroll
            for (int r = 0; r < 5; ++r) *(LAS f32x4*)(red + (ks * 5 + r) * 64 + c4 * 4) = acc[r];
            __syncthreads();
            if (tid < 320) { const int r = tid >> 6, c = tid & 63; float s = 0.f;
                for (int k2 = 0; k2 < 32; ++k2) s += red[(k2 * 5 + r) * 64 + c];
                ((float*)(ws + WS_MOD))[(size_t)(l * 5 + r) * 12288 + c0 + c] = s + a.in[I_ADAB][l * 12288 + c0 + c]; }
            __syncthreads();
        }
    }
    {
        float* cr = (float*)(ws + WS_ROPER); float* sr = cr + 2048 * 128; float* ca = (float*)(ws + WS_ROPEA); float* sa = ca + 2048 * 64;
        const int gt = bid * NTHR + tid, NT = G * NTHR;
        for (int idx = gt; idx < 2048 * 128; idx += NT) { const int t = idx >> 7, i = idx & 127, f = i & 63; const int pos = (i < 64) ? (t >> 6) : (t & 63);
            const float inv = powf(10000.f, -(float)f / 64.f), ang = (float)pos * inv; float s, c; sincosf(ang, &s, &c); cr[idx] = c; sr[idx] = s; }
        for (int idx = gt; idx < 2048 * 64; idx += NT) { const int t = idx >> 6, i = idx & 63, f = i & 31; const int pos = (i < 32) ? (t >> 6) : (t & 63);
            const float inv = powf(10000.f, -(float)f / 32.f), ang = (float)pos * inv; float s, c; sincosf(ang, &s, &c); ca[idx] = c; sa[idx] = s; }
    }
}

__device__ __forceinline__ void phase_norm(const float* srcX, const float* srcC, const float* nw, const float* mod  , int shoff, bf16_t* H, int nrows, int bid, int G, int wave, int lane) {
    const int gw = bid * NWAVES + wave, NGW = G * NWAVES;
    for (int row = gw; row < nrows; row += NGW) {
        const float* src = row < ML ? srcX + (size_t)row * DM : srcC + (size_t)(row - ML) * DM;
        const int mr = row < ML ? (row >> 11) : 4;
        const float* sh = mod + mr * 12288 + shoff; const float* sc = sh + DM;
        f32x4 v[8]; float ss = 0.f;
#pragma unroll
        for (int j = 0; j < 8; ++j) { v[j] = *(const f32x4*)(src + (lane + 64 * j) * 4); ss += (v[j][0] * v[j][0] + v[j][1] * v[j][1]) + (v[j][2] * v[j][2] + v[j][3] * v[j][3]); }
        const float rstd = 1.0f / sqrtf(wave_sum(ss) * (1.f / DM) + EPS);
#pragma unroll
        for (int j = 0; j < 8; ++j) { const int c = (lane + 64 * j) * 4;
            const f32x4 w = *(const f32x4*)(nw + c), s1 = *(const f32x4*)(sc + c), s0 = *(const f32x4*)(sh + c);
            const f32x4 h = (v[j] * rstd) * w * (1.f + s1) + s0;
            u32x2 o; o.x = pk2(h[0], h[1]); o.y = pk2(h[2], h[3]); *(u32x2*)(H + (size_t)row * DM + c) = o; }
    }
}
__device__ __forceinline__ void phase_final(const float* XS, const float* nw, float* out, int bid, int G, int wave, int lane) {
    const int gw = bid * NWAVES + wave, NGW = G * NWAVES;
    for (int row = gw; row < ML; row += NGW) {
        const float* src = XS + (size_t)row * DM;
        f32x4 v[8]; float ss = 0.f;
#pragma unroll
        for (int j = 0; j < 8; ++j) { v[j] = *(const f32x4*)(src + (lane + 64 * j) * 4); ss += (v[j][0] * v[j][0] + v[j][1] * v[j][1]) + (v[j][2] * v[j][2] + v[j][3] * v[j][3]); }
        const float rstd = 1.0f / sqrtf(wave_sum(ss) * (1.f / DM) + EPS);
#pragma unroll
        for (int j = 0; j < 8; ++j) { const int c = (lane + 64 * j) * 4; const f32x4 w = *(const f32x4*)(nw + c); *(f32x4*)(out + (size_t)row * DM + c) = (v[j] * rstd) * w; }
    }
}

constexpr int RP = 136;
constexpr int RT_BYTES = 128 * RP * 2;
__device__ __forceinline__ bf16x8 ret_trfrag(const LAS bf16_t* T, int k0, int c0, int lane) {
    const int i = lane & 15, g = lane >> 4, q = i >> 2, p = i & 3;
    const LAS bf16_t* a1 = T + (k0 + 8 * g + q) * RP + c0 + 4 * p;
    const s16x4 lo = __builtin_amdgcn_ds_read_tr16_b64_v4i16((LAS s16x4*)a1);
    const s16x4 hi = __builtin_amdgcn_ds_read_tr16_b64_v4i16((LAS s16x4*)(a1 + 4 * RP));
    return (bf16x8){lo[0], lo[1], lo[2], lo[3], hi[0], hi[1], hi[2], hi[3]};
}
__device__ __forceinline__ void ret_load_tile(LAS bf16_t* dst, const bf16_t* src, int ld, int tid) {
#pragma unroll
    for (int i = 0; i < 4; ++i) { const int id = tid + NTHR * i, row = id >> 4, cc = id & 15;
        *(LAS bf16x8*)(dst + row * RP + cc * 8) = *(const bf16x8*)(src + (size_t)row * ld + cc * 8); }
}
__device__ __forceinline__ void phase_retention(const bf16_t* Qb, const bf16_t* Kb, const bf16_t* Vb, bf16_t* OD, const float* logdecay, LAS unsigned char* lds, int bid, int G, int tid, int wave, int lane) {
    LAS bf16_t* QH = (LAS bf16_t*)lds; LAS bf16_t* KH = (LAS bf16_t*)(lds + RT_BYTES); LAS bf16_t* VV = (LAS bf16_t*)(lds + 2 * RT_BYTES); LAS bf16_t* PP = (LAS bf16_t*)(lds + 3 * RT_BYTES);
    const int ew = 16 * wave;
    const int qt0 = 2 * (wave >> 1), kt0 = 4 * (wave & 1);
    for (int u = bid; u < 256; u += G) {
        const int es = u & 3, dir = (u >> 2) & 1, h = (u >> 3) & 7, b = u >> 6, e0 = es * 128;
        const float lg2u = -expf(logdecay[dir * 8 + h]) * 1.4426950408889634f;
        f32x4 S[16];
#pragma unroll
        for (int i = 0; i < 16; ++i) S[i] = (f32x4){0.f, 0.f, 0.f, 0.f};
        for (int s = 0; s < 18; ++s) {
            int tid_o = tid; asm volatile("" : "+v"(tid_o)); const int lane_o = tid_o & 63, fr = lane_o & 15, g = lane_o >> 4;
            float lg2 = lg2u; asm volatile("" : "+v"(lg2));
            const bool isctx = s < 2;
            const int ci = dir == 0 ? (isctx ? s : s - 2) : (isctx ? 1 - s : 17 - s);
            const int row0 = isctx ? ML + b * CTXL + ci * 128 : b * SEQ + ci * 128;
            ret_load_tile(VV, Vb + (size_t)row0 * 4096 + h * 512 + e0, 4096, tid_o);
            ret_load_tile(QH, Qb + (size_t)row0 * 2048 + h * 256, 2048, tid_o);
            ret_load_tile(KH, Kb + (size_t)row0 * 2048 + h * 256, 2048, tid_o);
            __syncthreads();
            f32x4 sc[2][4], oi[8];
#pragma unroll
            for (int i = 0; i < 2; ++i)
#pragma unroll
                for (int j = 0; j < 4; ++j) sc[i][j] = (f32x4){0.f, 0.f, 0.f, 0.f};
#pragma unroll
            for (int i = 0; i < 8; ++i) oi[i] = (f32x4){0.f, 0.f, 0.f, 0.f};
#pragma unroll
            for (int hh = 0; hh < 2; ++hh) {
                if (hh == 1) {
                    __syncthreads();
                    ret_load_tile(QH, Qb + (size_t)row0 * 2048 + h * 256 + 128, 2048, tid_o);
                    ret_load_tile(KH, Kb + (size_t)row0 * 2048 + h * 256 + 128, 2048, tid_o);
                    __syncthreads();
                }
#pragma unroll
                for (int ks = 0; ks < 4; ++ks) {
                    bf16x8 qf[2], kf[4];
#pragma unroll
                    for (int a = 0; a < 2; ++a) qf[a] = *(const LAS bf16x8*)(QH + (16 * (qt0 + a) + fr) * RP + ks * 32 + 8 * g);
#pragma unroll
                    for (int c = 0; c < 4; ++c) kf[c] = *(const LAS bf16x8*)(KH + (16 * (kt0 + c) + fr) * RP + ks * 32 + 8 * g);
#pragma unroll
                    for (int a = 0; a < 2; ++a)
#pragma unroll
                        for (int c = 0; c < 4; ++c) sc[a][c] = __builtin_amdgcn_mfma_f32_16x16x32_bf16(kf[c], qf[a], sc[a][c], 0, 0, 0);
                    __builtin_amdgcn_sched_barrier(0);
                }
#pragma unroll
                for (int p = 0; p < 4; ++p) {
                    const f32x4 sa = S[8 * hh + 2 * p], sb = S[8 * hh + 2 * p + 1];
                    u32x4 bw; bw.x = pk2(sa[0], sa[1]); bw.y = pk2(sa[2], sa[3]); bw.z = pk2(sb[0], sb[1]); bw.w = pk2(sb[2], sb[3]);
                    const bf16x8 bfrag = __builtin_bit_cast(bf16x8, bw);
#pragma unroll
                    for (int nt = 0; nt < 8; ++nt) {
                        const LAS bf16_t* qa = QH + (16 * nt + fr) * RP + 32 * p + 4 * g;
                        const s16x4 lo = *(const LAS s16x4*)qa, hi = *(const LAS s16x4*)(qa + 16);
                        const bf16x8 afrag = (bf16x8){lo[0], lo[1], lo[2], lo[3], hi[0], hi[1], hi[2], hi[3]};
                        oi[nt] = __builtin_amdgcn_mfma_f32_16x16x32_bf16(afrag, bfrag, oi[nt], 0, 0, 0);
                    }
                    __builtin_amdgcn_sched_barrier(0);
                }
                { const float cd = __builtin_amdgcn_exp2f(lg2 * 128.f);
#pragma unroll
                for (int j = 0; j < 8; ++j) S[8 * hh + j] = S[8 * hh + j] * cd; }
#pragma unroll
                for (int ks = 0; ks < 4; ++ks) {
                    bf16x8 vf = ret_trfrag(VV, 32 * ks, ew, lane_o);
                    { float f[8]; unpack8(vf, f);
#pragma unroll
                      for (int jj = 0; jj < 8; ++jj) { const int m = 32 * ks + 8 * g + jj; f[jj] *= __builtin_amdgcn_exp2f(lg2 * (float)(dir == 0 ? 127 - m : m)); }
                      vf = __builtin_bit_cast(bf16x8, pack8f(f)); }
#pragma unroll
                    for (int j = 0; j < 8; ++j) { const bf16x8 kT = ret_trfrag(KH, 32 * ks, 16 * j, lane_o);
                        S[8 * hh + j] = __builtin_amdgcn_mfma_f32_16x16x32_bf16(kT, vf, S[8 * hh + j], 0, 0, 0); }
                    __builtin_amdgcn_sched_barrier(0);
                }
            }
#pragma unroll
            for (int a = 0; a < 2; ++a)
#pragma unroll
                for (int c = 0; c < 4; ++c) { const int n = 16 * (qt0 + a) + fr, m0 = 16 * (kt0 + c) + 4 * g; float pv[4];
#pragma unroll
                    for (int r = 0; r < 4; ++r) { const int m = m0 + r; const int dd = dir == 0 ? n - m : m - n; pv[r] = dd >= 0 ? sc[a][c][r] * __builtin_amdgcn_exp2f(lg2 * (float)dd) : 0.f; }
                    u32x2 w; w.x = pk2(pv[0], pv[1]); w.y = pk2(pv[2], pv[3]); *(LAS u32x2*)(PP + n * RP + m0) = w; }
            __syncthreads();
#pragma unroll
            for (int nt = 0; nt < 8; ++nt)
#pragma unroll
                for (int r = 0; r < 4; ++r) { const int n = 16 * nt + 4 * g + r; oi[nt][r] *= __builtin_amdgcn_exp2f(lg2 * (float)(dir == 0 ? n + 1 : 128 - n)); }
#pragma unroll
            for (int ks = 0; ks < 4; ++ks) { const bf16x8 vf = ret_trfrag(VV, 32 * ks, ew, lane_o);
#pragma unroll
                for (int nt = 0; nt < 8; ++nt) { const bf16x8 pf = *(const LAS bf16x8*)(PP + (16 * nt + fr) * RP + 32 * ks + 8 * g);
                    oi[nt] = __builtin_amdgcn_mfma_f32_16x16x32_bf16(pf, vf, oi[nt], 0, 0, 0); }
                __builtin_amdgcn_sched_barrier(0); }
            bf16_t* op = OD + (size_t)dir * MT * 4096 + (size_t)row0 * 4096 + h * 512 + e0 + ew + fr;
#pragma unroll
            for (int nt = 0; nt < 8; ++nt)
#pragma unroll
                for (int r = 0; r < 4; ++r) op[(size_t)(16 * nt + 4 * g + r) * 4096] = (bf16_t)(pk2(oi[nt][r], 0.f) & 0xffffu);
            __syncthreads();
        }
    }
}
__device__ __forceinline__ void phase_combine(const bf16_t* OD, const bf16_t* Gb, const float* gnw, bf16_t* Y, int bid, int G, int wave, int lane) {
    const int gw = bid * NWAVES + wave, NGW = G * NWAVES;
    for (int it = gw; it < MT * 8; it += NGW) {
        const int row = it >> 3, h = it & 7; const size_t off = (size_t)row * 4096 + h * 512 + lane * 8;
        float a[8], b2[8], gg[8];
        unpack8(*(const bf16x8*)(OD + off), a); unpack8(*(const bf16x8*)(OD + (size_t)MT * 4096 + off), b2); unpack8(*(const bf16x8*)(Gb + off), gg);
        float s = 0.f;
#pragma unroll
        for (int i = 0; i < 8; ++i) { a[i] += b2[i]; s += a[i]; }
        const float mu = wave_sum(s) * (1.f / 512.f); float q = 0.f;
#pragma unroll
        for (int i = 0; i < 8; ++i) { a[i] -= mu; q += a[i] * a[i]; }
        const float rstd = 1.0f / sqrtf(wave_sum(q) * (1.f / 512.f) + EPS);
        const f32x4 w0 = *(const f32x4*)(gnw + h * 512 + lane * 8), w1 = *(const f32x4*)(gnw + h * 512 + lane * 8 + 4);
        float o[8];
#pragma unroll
        for (int i = 0; i < 8; ++i) o[i] = a[i] * rstd * (i < 4 ? w0[i] : w1[i - 4]) * silu_f(gg[i]);
        *(u32x4*)(Y + off) = pack8f(o);
    }
}
__device__ __forceinline__ void phase_conv(const bf16_t* U, const float* cw, const float* cb, bf16_t* ACT, int nrows, int bid, int G, int tid) {
    const long gt = (long)bid * NTHR + tid, NT = (long)G * NTHR, total = (long)nrows * (FF / 8);
    for (long idx = gt; idx < total; idx += NT) {
        const int row = (int)(idx / (FF / 8)), f0 = (int)(idx % (FF / 8)) * 8;
        int t, len; if (row < ML) { t = row & (SEQ - 1); len = SEQ; } else { t = (row - ML) & (CTXL - 1); len = CTXL; }
        float xa[8], xb[8];
#pragma unroll
        for (int i = 0; i < 8; ++i) { xa[i] = cb[f0 + i]; xb[i] = cb[FF + f0 + i]; }
#pragma unroll
        for (int j = 0; j < 3; ++j) { const int tt = t + j - 1;
            if (tt >= 0 && tt < len) { float ua[8], ub[8]; const bf16_t* up = U + (size_t)(row + j - 1) * FF2 + f0;
                unpack8(*(const bf16x8*)up, ua); unpack8(*(const bf16x8*)(up + FF), ub);
                const float* wa = cw + j * FF2 + f0;
#pragma unroll
                for (int i = 0; i < 8; ++i) { xa[i] += ua[i] * wa[i]; xb[i] += ub[i] * wa[FF + i]; } } }
        float o[8];
#pragma unroll
        for (int i = 0; i < 8; ++i) o[i] = silu_f(xa[i]) * xb[i];
        *(u32x4*)(ACT + (size_t)row * FF + f0) = pack8f(o);
    }
}
__device__ __forceinline__ void phase_qknorm(const bf16_t* QKV, const float* qn, const float* kn, const float* cosa, const float* sina, bf16_t* Qn, bf16_t* Kn, bf16_t* Vn, int bid, int G, int wave, int lane) {
    const int gw = bid * NWAVES + wave, NGW = G * NWAVES;
    for (int it = gw; it < MT * 6; it += NGW) {
        const int row = it / 6, sg = it % 6, s = sg * 4 + (lane >> 4), i = lane & 15, d0 = 8 * i;
        float x[8]; unpack8(*(const bf16x8*)(QKV + (size_t)row * NAIN + s * 128 + d0), x);
        float ss = 0.f;
#pragma unroll
        for (int j = 0; j < 8; ++j) ss += x[j] * x[j];
        ss += __shfl_xor(ss, 1); ss += __shfl_xor(ss, 2); ss += __shfl_xor(ss, 4); ss += __shfl_xor(ss, 8);
        const bool latent = row < ML;
        if (s < 20) {
            const float rstd = 1.0f / sqrtf(ss * (1.f / 128.f) + EPS); const float* nw = (s < 16 ? qn : kn) + d0;
#pragma unroll
            for (int j = 0; j < 8; ++j) x[j] = x[j] * rstd * nw[j];
            if (latent) { const int t = row & (SEQ - 1); const f32x4 cs = *(const f32x4*)(cosa + t * 64 + 4 * i), sn = *(const f32x4*)(sina + t * 64 + 4 * i);
#pragma unroll
                for (int p = 0; p < 4; ++p) { const float x1 = x[2 * p], x2 = x[2 * p + 1]; x[2 * p] = x1 * cs[p] - x2 * sn[p]; x[2 * p + 1] = x1 * sn[p] + x2 * cs[p]; } }
        }
        const u32x4 o = pack8f(x);
        if (s < 16) { if (latent) *(u32x4*)(Qn + (size_t)row * DM + s * 128 + d0) = o; }
        else { const int b = latent ? (row >> 11) : ((row - ML) >> 8), key = latent ? CTXL + (row & (SEQ - 1)) : ((row - ML) & (CTXL - 1));
            bf16_t* dst = (s < 20 ? Kn : Vn) + ((size_t)b * SKV + key) * 512 + (s & 3) * 128 + d0; *(u32x4*)dst = o; }
    }
}
__device__ __forceinline__ void phase_attention(const bf16_t* Qn, const bf16_t* Kn, const bf16_t* Vn, bf16_t* O, unsigned char* lds_generic, int bid, int G, int tid) {
    for (int u = bid; u < 512; u += G) {
        const int grp = (u & 7) * 2 + (u >> 8), slot = (u >> 3) & 31, b = grp >> 2, kvh = grp & 3, h = kvh * 4 + (slot >> 3), qb = slot & 7;
        const size_t qoff = ((size_t)b * SEQ + qb * 256) * DM + h * 128, koff = (size_t)b * SKV * 512 + kvh * 128;
        att::attn_dense_body((const att::bf16*)(Qn + qoff), (const att::bf16*)(Kn + koff), (const att::bf16*)(Vn + koff), (att::bf16*)(O + qoff), SKV, (char*)lds_generic, tid);
        __syncthreads();
    }
}

__global__ void __launch_bounds__(NTHR, 2) mega(Args a) {
    extern __shared__ __attribute__((aligned(16))) unsigned char lds_raw[];
    LAS unsigned char* lds = (LAS unsigned char*)lds_raw;
    cg::grid_group grid = cg::this_grid();
    const int bid = blockIdx.x, G = gridDim.x;
    unsigned char* ws = a.ws;
    const float* MOD = (const float*)(ws + WS_MOD);
    float* XS = (float*)(ws + WS_XS); bf16_t* H = (bf16_t*)(ws + WS_H);
    unsigned char* R1 = ws + WS_R1; unsigned char* R2 = ws + WS_R2;
    auto run = [&](auto PC) {
        constexpr int p = decltype(PC)::value;
        int tid = threadIdx.x; asm volatile("" : "+v"(tid));
        const int lane = tid & 63, wave = __builtin_amdgcn_readfirstlane(tid >> 6);
        const int layer = p >= 10 ? 1 : 0;
        const float* mod = MOD + (size_t)layer * 5 * 12288;
        switch (PHSEL(p)) {
        case 0: phase_prologue(a, ws, lds, bid, G, tid, wave, lane); break;
        case 1: phase_norm(a.in[I_X], a.in[I_CTX], a.in[I_NORMW] + 0 * DM, mod, 0, H, MT, bid, G, wave, lane); break;
        case 6: phase_norm(XS, XS + (size_t)ML * DM, a.in[I_NORMW] + 1 * DM, mod, 3 * DM, H, MT, bid, G, wave, lane); break;
        case 10: phase_norm(XS, XS + (size_t)ML * DM, a.in[I_NORMW] + 2 * DM, mod, 0, H, MT, bid, G, wave, lane); break;
        case 15: phase_norm(XS, XS + (size_t)ML * DM, a.in[I_NORMW] + 3 * DM, mod, 3 * DM, H, ML, bid, G, wave, lane); break;
        case 2: {
            pg8::Gemm g{H, (const bf16_t*)(ws + WS_WRIN), MT, NRIN, DM}; pg8::StaticOrder S; S.init(MT, NRIN, G, bid);
            pg8::EpiRow8<pg8::FRope> E{{(bf16_t*)(R1 + R1_Q), (bf16_t*)(R1 + R1_K), (bf16_t*)(R1 + R1_V), (bf16_t*)(R1 + R1_G), (const float*)(ws + WS_ROPER), (const float*)(ws + WS_ROPER) + 2048 * 128, ML}};
            pg8::gemm_phase<pg8::EpiRow8<pg8::FRope>, pg8::StaticOrder, true, true>(lds, g, S, E, tid);
        } break;
        case 3: phase_retention((const bf16_t*)(R1 + R1_Q), (const bf16_t*)(R1 + R1_K), (const bf16_t*)(R1 + R1_V), (bf16_t*)R2, a.in[I_RLD], lds, bid, G, tid, wave, lane); break;
        case 4: phase_combine((const bf16_t*)R2, (const bf16_t*)(R1 + R1_G), a.in[I_RGN], (bf16_t*)(R1 + R1_V), bid, G, wave, lane); break;
        case 5: case 9: case 14: case 18: {
            const bf16_t* A; const bf16_t* Bt; int M, K; const float* bx; const float* bc; int goff;
            if (p == 5)       { A = (const bf16_t*)(R1 + R1_V); Bt = (const bf16_t*)(ws + WS_WROUT); M = MT; K = 2 * DM; bx = a.in[I_X]; bc = a.in[I_CTX]; goff = 2 * DM; }
            else if (p == 9)  { A = (const bf16_t*)R2; Bt = (const bf16_t*)(ws + WS_WDN); M = MT; K = FF; bx = XS; bc = XS + (size_t)ML * DM; goff = 5 * DM; }
            else if (p == 14) { A = (const bf16_t*)(R1 + R1_O); Bt = (const bf16_t*)(ws + WS_WAOUT); M = ML; K = DM; bx = XS; bc = XS + (size_t)ML * DM; goff = 2 * DM; }
            else              { A = (const bf16_t*)R2; Bt = (const bf16_t*)(ws + WS_WDN) + (size_t)DM * FF; M = ML; K = FF; bx = XS; bc = XS + (size_t)ML * DM; goff = 5 * DM; }
            pg8::Gemm g{A, Bt, M, DM, K}; pg8::StaticOrder S; S.init(M, DM, G, bid);
            pg8::EpiRow8<pg8::FRes> E{{bx, bc, XS, mod + goff, ML}};
            pg8::gemm_phase<pg8::EpiRow8<pg8::FRes>, pg8::StaticOrder, true, true>(lds, g, S, E, tid);
        } break;
        case 7: case 11: case 16: {
            const bf16_t* Bt; int M, N; bf16_t* O;
            if (p == 7)       { Bt = (const bf16_t*)(ws + WS_WUP); M = MT; N = FF2; O = (bf16_t*)R1; }
            else if (p == 11) { Bt = (const bf16_t*)(ws + WS_WAIN); M = MT; N = NAIN; O = (bf16_t*)R2; }
            else              { Bt = (const bf16_t*)(ws + WS_WUP) + (size_t)FF2 * DM; M = ML; N = FF2; O = (bf16_t*)R1; }
            pg8::Gemm g{H, Bt, M, N, DM}; pg8::StaticOrder S; S.init(M, N, G, bid);
            pg8::EpiRow8<pg8::FPlain> E{{O, N}};
            pg8::gemm_phase<pg8::EpiRow8<pg8::FPlain>, pg8::StaticOrder, true, true>(lds, g, S, E, tid);
        } break;
        case 8: phase_conv((const bf16_t*)R1, a.in[I_FCW], a.in[I_FCB], (bf16_t*)R2, MT, bid, G, tid); break;
        case 17: phase_conv((const bf16_t*)R1, a.in[I_FCW] + 3 * FF2, a.in[I_FCB] + FF2, (bf16_t*)R2, ML, bid, G, tid); break;
        case 12: phase_qknorm((const bf16_t*)R2, a.in[I_AQN], a.in[I_AKN], (const float*)(ws + WS_ROPEA), (const float*)(ws + WS_ROPEA) + 2048 * 64,
                              (bf16_t*)(R1 + R1_QN), (bf16_t*)(R1 + R1_KN), (bf16_t*)(R1 + R1_VN), bid, G, wave, lane); break;
        case 13: phase_attention((const bf16_t*)(R1 + R1_QN), (const bf16_t*)(R1 + R1_KN), (const bf16_t*)(R1 + R1_VN), (bf16_t*)(R1 + R1_O), lds_raw, bid, G, tid); break;
        case 19: phase_final(XS, a.in[I_FNW], a.out, bid, G, wave, lane); break;
        default: break;
        }
    };
#define RUNP(P) if (a.ph_lo <= (P) && (P) < a.ph_hi) { run(std::integral_constant<int, (P)>{}); if ((P) + 1 < a.ph_hi) grid.sync(); }
    RUNP(0) RUNP(1) RUNP(2) RUNP(3) RUNP(4) RUNP(5) RUNP(6) RUNP(7) RUNP(8) RUNP(9) RUNP(10) RUNP(11) RUNP(12) RUNP(13) RUNP(14) RUNP(15) RUNP(16) RUNP(17) RUNP(18) RUNP(19)
#undef RUNP
}

extern "C" void kernel_launch(void* const* d_in, const int* in_sizes, int n_in, void* d_out, int out_size, void* d_ws, size_t ws_size, hipStream_t stream) {
    static int grid = 0;
    if (grid == 0) {
        if (n_in != 20 || out_size != ML * DM || ws_size < WS_END) { fprintf(stderr, "kernel_launch: unexpected shapes: n_in %d out %d ws %zu (need %zu)\n", n_in, out_size, ws_size, (size_t)WS_END); grid = -1; return; }
        int dev = 0, cus = 0, per_cu = 0;
        hipGetDevice(&dev); hipDeviceGetAttribute(&cus, hipDeviceAttributeMultiprocessorCount, dev);
        if (hipFuncSetAttribute((const void*)mega, hipFuncAttributeMaxDynamicSharedMemorySize, LDS_BYTES) != hipSuccess) { fprintf(stderr, "kernel_launch: hipFuncSetAttribute failed\n"); grid = -1; return; }
        hipOccupancyMaxActiveBlocksPerMultiprocessor(&per_cu, (const void*)mega, NTHR, LDS_BYTES);
        if (per_cu < 1) { fprintf(stderr, "kernel_launch: occupancy query says %d blocks per CU\n", per_cu); per_cu = 1; }
        (void)hipGetLastError();
        grid = cus * 1;
        fprintf(stderr, "kernel_launch: grid %d (cus %d, per_cu %d), ws %zu need %zu\n", grid, cus, per_cu, ws_size, (size_t)WS_END);
    }
    if (grid < 0) return;
    Args a{};
    for (int i = 0; i < 20; ++i) a.in[i] = (const float*)d_in[i];
    a.out = (float*)d_out; a.ws = (unsigned char*)d_ws;
#if ONE_LAUNCH
    a.ph_lo = 0; a.ph_hi = NPH;
    void* args[] = {&a};
    hipError_t e = hipLaunchCooperativeKernel((const void*)mega, dim3(grid), dim3(NTHR), args, LDS_BYTES, stream);
    if (e != hipSuccess) fprintf(stderr, "kernel_launch: cooperative launch failed: %s (grid %d)\n", hipGetErrorString(e), grid);
#else
    for (int p = 0; p < NPH; ++p) { a.ph_lo = p; a.ph_hi = p + 1; hipLaunchKernelGGL(mega, dim3(grid), dim3(NTHR), LDS_BYTES, stream, a); }
    const hipError_t le = hipPeekAtLastError();
    if (le != hipSuccess) fprintf(stderr, "kernel_launch: launch failed: %s\n", hipGetErrorName(le));
#endif
}
```

```cpp
#include <hip/hip_runtime.h>
#include <hip/hip_bf16.h>
#include <hip/hip_cooperative_groups.h>
#include <cstdio>
#include <cstdint>
#include <cmath>
#include <type_traits>
namespace cg = cooperative_groups;
#ifndef ONE_LAUNCH
#define ONE_LAUNCH 1
#endif
#ifndef TIME_PHASE
#define TIME_PHASE -1
#endif
#define TIME_SCALE 4
#ifndef USE_CG_SYNC
#define USE_CG_SYNC 0
#endif
namespace pg8 {
#define PG8_LAS __attribute__((address_space(3)))
typedef unsigned short bf16_t;
typedef short bf16x8 __attribute__((ext_vector_type(8)));
typedef float f32x4 __attribute__((ext_vector_type(4)));
typedef unsigned u32x4 __attribute__((ext_vector_type(4)));
constexpr int BM = 256, BK = 64, HALF = 128, HTB = HALF * BK * 2  , STAGE_BYTES = 8 * HTB, NXCD = 8, WGM = 8;

__host__ __device__ __forceinline__ int lds_byte(int r, int c) { const int st = (r >> 4) * 2 + (c >> 5), rr = r & 15, cc = c & 31, ob = rr * 64 + cc * 2; return st * 1024 + (ob ^ (((ob >> 9) & 1) << 5)); }
__host__ __device__ __forceinline__ void stage_rc(int b, int& R, int& C) { const int st = b / 1024, sb = b % 1024, swz = sb ^ (((sb >> 9) & 1) << 5); R = (st >> 1) * 16 + swz / 64; C = (st & 1) * 32 + (swz % 64) / 2; }
__host__ __device__ __forceinline__ int perm32(int rho) { const int n = rho >> 4, i = rho & 15; return 8 * (i >> 2) + 4 * n + (i & 3); }

struct Unit { int pm, pn; };
struct Gemm { const bf16_t* A; const bf16_t* Bt; int M, N, K; };

struct StaticOrder {
    int nM, nN, nwg, G, c;
    __host__ __device__ void init(int M, int N, int G_, int c_) { nM = M / BM; nN = N / BM; nwg = nM * nN; G = G_; c = c_; }
    __host__ __device__ bool next(int i, Unit& u) const {
        const long L = (long)i * G + c; if (L >= nwg) return false;
        int wgid = (int)L; { const int q = nwg / NXCD, r = nwg % NXCD, xcd = wgid % NXCD, off = wgid / NXCD; wgid = (xcd < r ? xcd * (q + 1) : r * (q + 1) + (xcd - r) * q) + off; }
        const int nig = WGM * nN, gid = wgid / nig, fm = gid * WGM, gsz = (nM - fm) < WGM ? (nM - fm) : WGM;
        u.pm = fm + ((wgid % nig) % gsz); u.pn = (wgid % nig) / gsz; return true;
    }
    __device__ __forceinline__ void a_ready(const Unit&) const {}
    __device__ __forceinline__ void done(const Unit&) const {}
};

__device__ __forceinline__ unsigned cvt_pk_bf16(float lo, float hi) { unsigned r; asm volatile("v_cvt_pk_bf16_f32 %0, %1, %2" : "=v"(r) : "v"(lo), "v"(hi)); return r; }
typedef float f32x2 __attribute__((ext_vector_type(2)));
template <class F> struct EpiRow8 {
    static constexpr bool PERM = true, AFTER_DRAIN = false; F f;
    __device__ __forceinline__ void operator()(const f32x4 (&acc)[2][2][4][2], const Unit& u, int wr, int wc, int fr, int fq) const {
        const int row0 = u.pm * BM + wr * 64 + fr, col0 = u.pn * BM + wc * 32 + 8 * fq;
#pragma unroll
        for (int ai = 0; ai < 2; ++ai)
#pragma unroll
            for (int m = 0; m < 4; ++m)
#pragma unroll
                for (int bj = 0; bj < 2; ++bj) f.apply(row0 + ai * HALF + m * 16, col0 + bj * HALF, acc[ai][bj][m][0], acc[ai][bj][m][1]);
    }
};
__device__ __forceinline__ u32x4 pack8(const f32x4 a, const f32x4 b) { u32x4 w; w.x = cvt_pk_bf16(a[0], a[1]); w.y = cvt_pk_bf16(a[2], a[3]); w.z = cvt_pk_bf16(b[0], b[1]); w.w = cvt_pk_bf16(b[2], b[3]); return w; }
struct FPlain {
    bf16_t* O; int ldc;
    __device__ __forceinline__ void apply(int row, int col, f32x4 v0, f32x4 v1) const { *(u32x4*)(O + (size_t)row * ldc + col) = pack8(v0, v1); }
};
struct FRope {
    bf16_t *Q, *K, *V, *G; const float* cosr; const float* sinr; int ML;
    __device__ __forceinline__ void apply(int row, int col, f32x4 v0, f32x4 v1) const {
        if (col < 4096) {
            const bool isk = col >= 2048; const int c = col & 2047;
            if (isk) { v0 = v0 * 0.0625f; v1 = v1 * 0.0625f; }
            if (row < ML) {
                const int t = row & 2047, pi = (c & 255) >> 1;
                const f32x4 cs = *(const f32x4*)(cosr + t * 128 + pi), sn = *(const f32x4*)(sinr + t * 128 + pi);
                f32x4 a, b;
                a[0] = v0[0] * cs[0] - v0[1] * sn[0]; a[1] = v0[0] * sn[0] + v0[1] * cs[0];
                a[2] = v0[2] * cs[1] - v0[3] * sn[1]; a[3] = v0[2] * sn[1] + v0[3] * cs[1];
                b[0] = v1[0] * cs[2] - v1[1] * sn[2]; b[1] = v1[0] * sn[2] + v1[1] * cs[2];
                b[2] = v1[2] * cs[3] - v1[3] * sn[3]; b[3] = v1[2] * sn[3] + v1[3] * cs[3];
                v0 = a; v1 = b;
            }
            *(u32x4*)((isk ? K : Q) + (size_t)row * 2048 + c) = pack8(v0, v1);
        } else if (col < 8192) { *(u32x4*)(V + (size_t)row * 4096 + (col - 4096)) = pack8(v0, v1); }
        else { *(u32x4*)(G + (size_t)row * 4096 + (col - 8192)) = pack8(v0, v1); }
    }
};
struct FRes {
    const float* baseX; const float* baseC; float* XS; const float* gate; int ML;
    __device__ __forceinline__ void apply(int row, int col, f32x4 v0, f32x4 v1) const {
        const int mr = row < ML ? (row >> 11) : 4;
        const float* b = (row < ML ? baseX + (size_t)row * 2048 : baseC + (size_t)(row - ML) * 2048) + col;
        const float* gp = gate + mr * 12288 + col;
        const f32x4 b0 = *(const f32x4*)b, b1 = *(const f32x4*)(b + 4), g0 = *(const f32x4*)gp, g1 = *(const f32x4*)(gp + 4);
        float* o = XS + (size_t)row * 2048 + col;
        *(f32x4*)o = b0 + g0 * v0; *(f32x4*)(o + 4) = b1 + g1 * v1;
    }
};
template <class Epi, class Sched, bool ALIGN_EPI = false, bool SP2 = false>
__device__ __forceinline__ void gemm_phase(PG8_LAS unsigned char* lds, const Gemm g, const Sched& S, const Epi& E, const int tid) {
    const int wid = __builtin_amdgcn_readfirstlane(tid >> 6), lane = tid & 63, wr = wid >> 2, wc = wid & 3, fr = lane & 15, fq = lane >> 4;
    const int K = g.K, nt = K / BK;
    unsigned voffA[2], voffB[2];
#pragma unroll
    for (int i = 0; i < 2; ++i) { int R, C; stage_rc(tid * 16 + i * 8192, R, C); const int Rb = Epi::PERM ? ((R & ~31) + perm32(R & 31)) : R;
        voffA[i] = (unsigned)(R * K + C) * 2u; voffB[i] = (unsigned)(Rb * K + C) * 2u; }
    const size_t kstep = (size_t)(BK * 2);
    const size_t hstep = (size_t)HALF * K * 2;
    const size_t tstep = 2 * hstep;
    const unsigned ldsw = (unsigned)wid * 1024u;
    const int aoff = lds_byte(wr * 64 + fr, fq * 8), boff = lds_byte(wc * 32 + fr, fq * 8);
#define PG8_SA(b, h) (((b) * 2 + (h)) * HTB)
#define PG8_SB(b, h) ((4 + (b) * 2 + (h)) * HTB)
#define PG8_STAGE(bufoff, gbase, voff) do { _Pragma("unroll") for (int _i = 0; _i < 2; ++_i) \
        __builtin_amdgcn_global_load_lds((const unsigned*)((const char*)(gbase) + (voff)[_i]), (PG8_LAS unsigned*)(lds + (bufoff) + ldsw + _i * 8192), 16, 0, 0); } while (0)
#define PG8_LDA(dst, b, h) do { _Pragma("unroll") for (int m = 0; m < 4; ++m) _Pragma("unroll") for (int k = 0; k < 2; ++k) dst[m][k] = *(const PG8_LAS bf16x8*)(lds + PG8_SA(b, h) + aoff + m * 2048 + k * 1024); } while (0)
#define PG8_LDB(dst, b, h) do { _Pragma("unroll") for (int n = 0; n < 2; ++n) _Pragma("unroll") for (int k = 0; k < 2; ++k) dst[n][k] = *(const PG8_LAS bf16x8*)(lds + PG8_SB(b, h) + boff + n * 2048 + k * 1024); } while (0)
#define PG8_MMA(ai, bj, At, Bt) do { __builtin_amdgcn_s_setprio(1); _Pragma("unroll") for (int m = 0; m < 4; ++m) _Pragma("unroll") for (int n = 0; n < 2; ++n) _Pragma("unroll") for (int k = 0; k < 2; ++k) \
        acc[ai][bj][m][n] = __builtin_amdgcn_mfma_f32_16x16x32_bf16(Bt[n][k], At[m][k], acc[ai][bj][m][n], 0, 0, 0); __builtin_amdgcn_s_setprio(0); } while (0)
#define PG8_WAIT_V(n) asm volatile("s_waitcnt vmcnt(" #n ")" ::: "memory")
#define PG8_WAIT_L(n) asm volatile("s_waitcnt lgkmcnt(" #n ")" ::: "memory")
#define PG8_BAR __builtin_amdgcn_s_barrier()
#define PG8_SCHED __builtin_amdgcn_sched_barrier(0)
    Unit cur, nxt; int ui = 0;
    if (!S.next(0, cur)) return;
    f32x4 acc[2][2][4][2];
#pragma unroll
    for (int a = 0; a < 2; ++a)
#pragma unroll
        for (int b = 0; b < 2; ++b)
#pragma unroll
            for (int m = 0; m < 4; ++m)
#pragma unroll
                for (int n = 0; n < 2; ++n) acc[a][b][m][n] = (f32x4){0.f, 0.f, 0.f, 0.f};
    bf16x8 At[4][2], B0[2][2], B1[2][2];
    const char* cA = (const char*)g.A + (size_t)cur.pm * tstep; const char* cB = (const char*)g.Bt + (size_t)cur.pn * tstep;
    S.a_ready(cur);
    if constexpr (SP2) {
        PG8_STAGE(PG8_SB(0, 0), cB, voffB); PG8_STAGE(PG8_SB(0, 1), cB + hstep, voffB); PG8_STAGE(PG8_SA(0, 0), cA, voffA); PG8_STAGE(PG8_SA(0, 1), cA + hstep, voffA);
        if (wr == 1) PG8_BAR;
        PG8_WAIT_V(2); PG8_BAR;
        PG8_STAGE(PG8_SB(1, 0), cB + kstep, voffB); PG8_STAGE(PG8_SA(1, 0), cA + kstep, voffA); PG8_STAGE(PG8_SB(1, 1), cB + hstep + kstep, voffB);
        PG8_WAIT_V(6); PG8_BAR;
    } else {
        PG8_STAGE(PG8_SB(0, 0), cB, voffB); PG8_STAGE(PG8_SA(0, 0), cA, voffA); PG8_STAGE(PG8_SB(0, 1), cB + hstep, voffB); PG8_STAGE(PG8_SA(0, 1), cA + hstep, voffA);
        if (wr == 1) PG8_BAR;
        PG8_WAIT_V(4); PG8_BAR;
        PG8_STAGE(PG8_SB(1, 0), cB + kstep, voffB); PG8_STAGE(PG8_SA(1, 0), cA + kstep, voffA); PG8_STAGE(PG8_SB(1, 1), cB + hstep + kstep, voffB);
        PG8_WAIT_V(6); PG8_BAR;
    }
    for (;;) {
        const bool has_next = S.next(ui + 1, nxt);
        const char* nA = has_next ? (const char*)g.A + (size_t)nxt.pm * tstep : cA; const char* nB = has_next ? (const char*)g.Bt + (size_t)nxt.pn * tstep : cB;
        for (int t = 0; t < nt; t += 2) {
            const bool last = (t == nt - 2);
            const char* a1 = cA + (size_t)(t + 1) * kstep;
            const char* a2 = last ? nA : cA + (size_t)(t + 2) * kstep; const char* b2 = last ? nB : cB + (size_t)(t + 2) * kstep;
            const char* a3 = a2 + kstep; const char* b3 = b2 + kstep;
            if (last && has_next) S.a_ready(nxt);
            if constexpr (SP2) {
            PG8_LDB(B0, 0, 0); PG8_LDB(B1, 0, 1); PG8_SCHED; PG8_LDA(At, 0, 0); PG8_STAGE(PG8_SA(1, 1), a1 + hstep, voffA);
            PG8_WAIT_V(8); PG8_WAIT_L(0); PG8_BAR; PG8_MMA(0, 0, At, B0); PG8_MMA(0, 1, At, B1); PG8_BAR; PG8_SCHED;
            PG8_LDA(At, 0, 1); PG8_STAGE(PG8_SB(0, 0), b2, voffB); PG8_STAGE(PG8_SB(0, 1), b2 + hstep, voffB); PG8_STAGE(PG8_SA(0, 0), a2, voffA);
            PG8_WAIT_V(8); PG8_WAIT_L(0); PG8_BAR; PG8_MMA(1, 0, At, B0); PG8_MMA(1, 1, At, B1); PG8_BAR; PG8_SCHED;
            PG8_LDB(B0, 1, 0); PG8_LDB(B1, 1, 1); PG8_SCHED; PG8_LDA(At, 1, 0); PG8_STAGE(PG8_SA(0, 1), a2 + hstep, voffA);
            PG8_WAIT_V(8); PG8_WAIT_L(0); PG8_BAR; PG8_MMA(0, 0, At, B0); PG8_MMA(0, 1, At, B1); PG8_BAR; PG8_SCHED;
            PG8_LDA(At, 1, 1); PG8_STAGE(PG8_SB(1, 0), b3, voffB); PG8_STAGE(PG8_SB(1, 1), b3 + hstep, voffB); PG8_STAGE(PG8_SA(1, 0), a3, voffA);
            PG8_WAIT_V(8); PG8_WAIT_L(0); PG8_BAR; PG8_MMA(1, 0, At, B0); PG8_MMA(1, 1, At, B1); PG8_BAR; PG8_SCHED;
            } else {
            PG8_LDB(B0, 0, 0); PG8_SCHED; PG8_LDA(At, 0, 0); PG8_STAGE(PG8_SA(1, 1), a1 + hstep, voffA);
            PG8_WAIT_L(8); PG8_BAR; PG8_WAIT_L(0); PG8_MMA(0, 0, At, B0); PG8_BAR; PG8_SCHED;
            PG8_LDB(B1, 0, 1); PG8_STAGE(PG8_SB(0, 0), b2, voffB);
            PG8_BAR; PG8_WAIT_L(0); PG8_MMA(0, 1, At, B1); PG8_BAR;
            PG8_LDA(At, 0, 1); PG8_STAGE(PG8_SA(0, 0), a2, voffA);
            PG8_BAR; PG8_WAIT_L(0); PG8_MMA(1, 0, At, B0); PG8_BAR; PG8_SCHED;
            PG8_STAGE(PG8_SB(0, 1), b2 + hstep, voffB);
            PG8_WAIT_V(6); PG8_BAR; PG8_MMA(1, 1, At, B1); PG8_BAR;
            PG8_LDB(B0, 1, 0); PG8_SCHED; PG8_LDA(At, 1, 0); PG8_STAGE(PG8_SA(0, 1), a2 + hstep, voffA);
            PG8_WAIT_L(8); PG8_BAR; PG8_WAIT_L(0); PG8_MMA(0, 0, At, B0); PG8_BAR; PG8_SCHED;
            PG8_LDB(B1, 1, 1); PG8_STAGE(PG8_SB(1, 0), b3, voffB);
            PG8_BAR; PG8_WAIT_L(0); PG8_MMA(0, 1, At, B1); PG8_BAR;
            PG8_LDA(At, 1, 1); PG8_STAGE(PG8_SA(1, 0), a3, voffA);
            PG8_BAR; PG8_WAIT_L(0); PG8_MMA(1, 0, At, B0); PG8_BAR; PG8_SCHED;
            PG8_STAGE(PG8_SB(1, 1), b3 + hstep, voffB);
            PG8_WAIT_V(6); PG8_BAR; PG8_MMA(1, 1, At, B1); PG8_BAR;
            }
        }
        if constexpr (ALIGN_EPI) { if (wr == 0) PG8_BAR; }
        if constexpr (!Epi::AFTER_DRAIN) { E(acc, cur, wr, wc, fr, fq); S.done(cur); }
        if (!has_next) break;
#pragma unroll
        for (int a = 0; a < 2; ++a)
#pragma unroll
            for (int b = 0; b < 2; ++b)
#pragma unroll
                for (int m = 0; m < 4; ++m)
#pragma unroll
                    for (int n = 0; n < 2; ++n) acc[a][b][m][n] = (f32x4){0.f, 0.f, 0.f, 0.f};
        cur = nxt; cA = nA; cB = nB; ++ui;
        if constexpr (ALIGN_EPI) { if (wr == 1) PG8_BAR; }
    }
    PG8_WAIT_V(0);
    if constexpr (!ALIGN_EPI) { if (wr == 0) PG8_BAR; }
    PG8_BAR;
    if constexpr (Epi::AFTER_DRAIN) { E.fused(acc, cur, wr, wc, fr, fq, lds, wid, lane); S.done(cur); }
#undef PG8_SA
#undef PG8_SB
#undef PG8_STAGE
#undef PG8_LDA
#undef PG8_LDB
#undef PG8_MMA
#undef PG8_WAIT_V
#undef PG8_WAIT_L
#undef PG8_BAR
#undef PG8_SCHED
}
}

namespace att {
using bf16 = __hip_bfloat16;
constexpr int D = 128, NW = 8, QBLK = 32, KVBLK = 64;
constexpr float SCALE = 0.088388347648318440f;
constexpr float THR = 8.f;
constexpr int LDQ = 2048, LDK = 512, LDO = 2048;
constexpr size_t SHM_V = KVBLK * D * 2, SHM_K = KVBLK * D * 2, SHM_ATTN = 2 * SHM_V + 2 * SHM_K + NW * 64 * 4;
using bf16x8 = __attribute__((ext_vector_type(8))) short;
using s16x4  = __attribute__((ext_vector_type(4))) short;
using f32x16 = __attribute__((ext_vector_type(16))) float;
using u32x4  = __attribute__((ext_vector_type(4))) unsigned;
#define KSWZ(row, colB) ((row) * 256 + ((colB) ^ (((row) & 7) << 4)))
#define SBAR() __builtin_amdgcn_sched_barrier(0)
__device__ __forceinline__ int crow(int r, int hi) { return (r & 3) + 8 * (r >> 2) + 4 * hi; }
__device__ __forceinline__ unsigned cvtpk(float lo, float hi) { unsigned r; asm volatile("v_cvt_pk_bf16_f32 %0, %1, %2" : "=v"(r) : "v"(lo), "v"(hi)); return r; }
__device__ __forceinline__ void partialSM(f32x16& p0, f32x16& p1, float& m_reg, float& mn, float& alpha) {
  constexpr float C = SCALE * 1.4426950408889634f;
  float pmax = p0[0]; for (int r = 1; r < 16; ++r) pmax = fmaxf(pmax, p0[r]); for (int r = 0; r < 16; ++r) pmax = fmaxf(pmax, p1[r]);
  { auto rr = __builtin_amdgcn_permlane32_swap(__float_as_uint(pmax), __float_as_uint(pmax), false, false);
    pmax = fmaxf(__uint_as_float(rr[0]), __uint_as_float(rr[1])); }
  if (__builtin_expect(__all(pmax - m_reg <= THR / SCALE), 1)) { mn = m_reg; alpha = 1.f; }
  else { mn = fmaxf(m_reg, pmax); alpha = __builtin_amdgcn_exp2f((m_reg - mn) * C); m_reg = mn; }
  float mnC = -mn * C;
  for (int r = 0; r < 16; ++r) p0[r] = fmaf(p0[r], C, mnC); for (int r = 0; r < 16; ++r) p1[r] = fmaf(p1[r], C, mnC);
  for (int r = 0; r < 16; ++r) p0[r] = __builtin_amdgcn_exp2f(p0[r]);
}
__device__ __forceinline__ void finishSM(f32x16& p0, f32x16& p1, float alpha, float& l_reg, bf16x8& pa0, bf16x8& pa1, bf16x8& pa2, bf16x8& pa3) {
  for (int r = 0; r < 16; ++r) p1[r] = __builtin_amdgcn_exp2f(p1[r]);
  float ps = 0; for (int r = 0; r < 16; ++r) ps += p0[r]; for (int r = 0; r < 16; ++r) ps += p1[r];
  { auto rr = __builtin_amdgcn_permlane32_swap(__float_as_uint(ps), __float_as_uint(ps), false, false);
    ps = __uint_as_float(rr[0]) + __uint_as_float(rr[1]); }
  l_reg = l_reg * alpha + ps;
#define PK4(P, BASE, OUT) do { unsigned a0 = cvtpk(P[BASE + 0], P[BASE + 1]), a1 = cvtpk(P[BASE + 2], P[BASE + 3]);   \
    unsigned b0 = cvtpk(P[BASE + 4], P[BASE + 5]), b1 = cvtpk(P[BASE + 6], P[BASE + 7]);                              \
    auto r0 = __builtin_amdgcn_permlane32_swap(a0, b0, false, false); auto r1 = __builtin_amdgcn_permlane32_swap(a1, b1, false, false); \
    u32x4 w = {r0[0], r1[0], r0[1], r1[1]}; OUT = *reinterpret_cast<bf16x8*>(&w); } while (0)
  PK4(p0, 0, pa0); PK4(p0, 8, pa1); PK4(p1, 0, pa2); PK4(p1, 8, pa3);
#undef PK4
}
__device__ __forceinline__ void qkt(f32x16& p0, f32x16& p1, const bf16* Ks, const bf16x8* qr, int r32, int hi) {
  p0 = f32x16{}; p1 = f32x16{};
  for (int d0 = 0; d0 < 8; ++d0) { int cb = (d0 * 16 + hi * 8) * 2;
    bf16x8 b0 = *reinterpret_cast<const bf16x8*>((const char*)Ks + KSWZ(r32, cb));
    bf16x8 b1 = *reinterpret_cast<const bf16x8*>((const char*)Ks + KSWZ(32 + r32, cb));
    p0 = __builtin_amdgcn_mfma_f32_32x32x16_bf16(b0, qr[d0], p0, 0, 0, 0);
    p1 = __builtin_amdgcn_mfma_f32_32x32x16_bf16(b1, qr[d0], p1, 0, 0, 0); }
}
__device__ __forceinline__ int v_st(int k, int c) { const int kk = (k & ~0xC) | ((k & 4) << 1) | ((k & 8) >> 1); return ((kk >> 3) * 4 + (c >> 5)) * 512 + ((kk & 7) * 32 + (c & 31)) * 2; }
__device__ __forceinline__ int v_rd_base(int lane) { return ((lane & 3) << 3) | (((lane >> 2) & 3) << 6) | (((lane >> 4) & 1) << 5) | (((lane >> 5) & 1) << 8); }
constexpr int v_rd_off(int d0, int ks, int half) { return d0 * 512 + ks * 4096 + half * 2048; }
template <int OFF> __device__ __forceinline__ s16x4 tr_read(int vb) {
  s16x4 r; asm volatile("ds_read_b64_tr_b16 %0, %1 offset:%2" : "=&v"(r) : "v"(vb), "i"(OFF) : "memory"); return r;
}
template <int D0> __device__ __forceinline__ void pv_one(f32x16& od, int vb, bf16x8 pa0, bf16x8 pa1, bf16x8 pa2, bf16x8 pa3) {
  const s16x4 l0 = tr_read<v_rd_off(D0, 0, 0)>(vb), h0 = tr_read<v_rd_off(D0, 0, 1)>(vb), l1 = tr_read<v_rd_off(D0, 1, 0)>(vb), h1 = tr_read<v_rd_off(D0, 1, 1)>(vb);
  const s16x4 l2 = tr_read<v_rd_off(D0, 2, 0)>(vb), h2 = tr_read<v_rd_off(D0, 2, 1)>(vb), l3 = tr_read<v_rd_off(D0, 3, 0)>(vb), h3 = tr_read<v_rd_off(D0, 3, 1)>(vb);
  asm volatile("s_waitcnt lgkmcnt(0)" ::: "memory"); SBAR();
#define PK(L, H) (bf16x8){L[0], L[1], L[2], L[3], H[0], H[1], H[2], H[3]}
  od = __builtin_amdgcn_mfma_f32_32x32x16_bf16(pa0, PK(l0, h0), od, 0, 0, 0);
  od = __builtin_amdgcn_mfma_f32_32x32x16_bf16(pa1, PK(l1, h1), od, 0, 0, 0);
  od = __builtin_amdgcn_mfma_f32_32x32x16_bf16(pa2, PK(l2, h2), od, 0, 0, 0);
  od = __builtin_amdgcn_mfma_f32_32x32x16_bf16(pa3, PK(l3, h3), od, 0, 0, 0);
#undef PK
}
__device__ __forceinline__ void pv_d0(f32x16* o, int vb, bf16x8 pa0, bf16x8 pa1, bf16x8 pa2, bf16x8 pa3) {
  pv_one<0>(o[0], vb, pa0, pa1, pa2, pa3); pv_one<1>(o[1], vb, pa0, pa1, pa2, pa3); pv_one<2>(o[2], vb, pa0, pa1, pa2, pa3); pv_one<3>(o[3], vb, pa0, pa1, pa2, pa3);
}
__device__ __forceinline__ void attn_dense_body(const bf16* __restrict__ Qb, const bf16* __restrict__ Kh, const bf16* __restrict__ Vh,
                                                bf16* __restrict__ Ob, int seq, char* lds, const int tid) {
  const int wid = tid >> 6, lane = tid & 63, r32 = lane & 31, hi = lane >> 5;
  bf16* V_lds = (bf16*)lds; bf16* K_lds = (bf16*)(lds + 2 * SHM_V);
  float* ws = (float*)(lds + 2 * SHM_V + 2 * SHM_K) + wid * 64; float* li_l = ws; float* al_l = ws + 32;
  float m_reg = -1e30f, l_reg = 0; f32x16 o[4] = {}; bf16x8 qr[8];
  const bf16* Qw = Qb + (long)(wid * QBLK + r32) * LDQ + hi * 8;
#pragma unroll
  for (int d0 = 0; d0 < 8; ++d0) qr[d0] = *reinterpret_cast<const bf16x8*>(Qw + d0 * 16);
  const int sr = tid >> 4, sc = (tid & 15) * 8, vst0 = v_st(sr, sc), vst1 = v_st(32 + sr, sc);
  const int vb0 = (int)(uintptr_t)V_lds + v_rd_base(lane);
  struct { bf16x8 vs0, vs1, ks0, ks1; } sr_[2];
#define SLOAD(i, k0) do { sr_[i].vs0 = *reinterpret_cast<const bf16x8*>(&Vh[(long)((k0) + sr) * LDK + sc]); sr_[i].vs1 = *reinterpret_cast<const bf16x8*>(&Vh[(long)((k0) + 32 + sr) * LDK + sc]); \
    sr_[i].ks0 = *reinterpret_cast<const bf16x8*>(&Kh[(long)((k0) + sr) * LDK + sc]); sr_[i].ks1 = *reinterpret_cast<const bf16x8*>(&Kh[(long)((k0) + 32 + sr) * LDK + sc]); } while (0)
#define SWRITE(b, i) do { *(bf16x8*)((char*)V_lds + (b) * SHM_V + vst0) = sr_[i].vs0;          \
    *(bf16x8*)((char*)V_lds + (b) * SHM_V + vst1) = sr_[i].vs1; int kc = sc * 2;               \
    *(bf16x8*)((char*)K_lds + (b) * SHM_K + KSWZ(sr, kc)) = sr_[i].ks0;                       \
    *(bf16x8*)((char*)K_lds + (b) * SHM_K + KSWZ(32 + sr, kc)) = sr_[i].ks1; } while (0)
#define SWAIT() do { asm volatile("s_waitcnt vmcnt(4)" ::: "memory"); } while (0)
#define RESC(a) do { if (__any((a) < 1.f)) { if (hi == 0) al_l[r32] = (a); asm volatile("s_waitcnt lgkmcnt(0)" ::: "memory"); \
    for (int d = 0; d < 4; ++d) for (int r = 0; r < 16; ++r) o[d][r] *= al_l[crow(r, hi)]; } } while (0)
  f32x16 pA0, pA1, pB0, pB1; float mnA, mnB, alA, alB; bf16x8 pa0, pa1, pa2, pa3; const int NT = seq / KVBLK;
  constexpr int SE = 0, SO = 1;
  SLOAD(SE, 0); asm volatile("s_waitcnt vmcnt(0)" ::: "memory"); SWRITE(0, SE); __syncthreads();
  qkt(pA0, pA1, K_lds, qr, r32, hi); partialSM(pA0, pA1, m_reg, mnA, alA);
  SLOAD(SO, KVBLK); { if (2 < NT) SLOAD(SE, 2 * KVBLK); }
  SWAIT(); SWRITE(1, SO); __syncthreads();
  for (int j = 1; j + 1 < NT; j += 2) {
    SBAR(); qkt(pB0, pB1, (bf16*)((char*)K_lds + SHM_K), qr, r32, hi);
    finishSM(pA0, pA1, alA, l_reg, pa0, pa1, pa2, pa3); SBAR();
    SLOAD(SO, (j + 2) * KVBLK); SBAR();
    pv_d0(o, vb0, pa0, pa1, pa2, pa3); partialSM(pB0, pB1, m_reg, mnB, alB);
    __syncthreads(); SWAIT(); SWRITE(0, SE);
    RESC(alB); __syncthreads();
    SBAR(); qkt(pA0, pA1, K_lds, qr, r32, hi);
    finishSM(pB0, pB1, alB, l_reg, pa0, pa1, pa2, pa3); SBAR();
    if (j + 3 < NT) SLOAD(SE, (j + 3) * KVBLK); SBAR();
    pv_d0(o, vb0 + (int)SHM_V, pa0, pa1, pa2, pa3); partialSM(pA0, pA1, m_reg, mnA, alA);
    __syncthreads(); SWAIT(); SWRITE(1, SO);
    RESC(alA); __syncthreads();
  }
  SBAR(); qkt(pB0, pB1, (bf16*)((char*)K_lds + SHM_K), qr, r32, hi);
  finishSM(pA0, pA1, alA, l_reg, pa0, pa1, pa2, pa3); SBAR();
  pv_d0(o, vb0, pa0, pa1, pa2, pa3); partialSM(pB0, pB1, m_reg, mnB, alB);
  __syncthreads(); RESC(alB);
  finishSM(pB0, pB1, alB, l_reg, pa0, pa1, pa2, pa3); SBAR();
  pv_d0(o, vb0 + (int)SHM_V, pa0, pa1, pa2, pa3);
  if (hi == 0) li_l[r32] = l_reg; asm volatile("s_waitcnt lgkmcnt(0)" ::: "memory");
  float rli[16];
#pragma unroll
  for (int r = 0; r < 16; ++r) rli[r] = __builtin_amdgcn_rcpf(li_l[crow(r, hi)]);
  bf16* Ow = Ob + (long)(wid * QBLK) * LDO;
#pragma unroll
  for (int r = 0; r < 16; ++r) { int orow = crow(r, hi);
    for (int d0 = 0; d0 < 4; ++d0) Ow[(long)orow * LDO + d0 * 32 + r32] = __float2bfloat16(o[d0][r] * rli[r]); }
#undef SLOAD
#undef SWRITE
#undef SWAIT
#undef RESC
}
}

typedef unsigned short bf16_t;
typedef short bf16x8 __attribute__((ext_vector_type(8)));
typedef short s16x4 __attribute__((ext_vector_type(4)));
typedef float f32x4 __attribute__((ext_vector_type(4)));
typedef unsigned u32x4 __attribute__((ext_vector_type(4)));
typedef unsigned u32x2 __attribute__((ext_vector_type(2)));
#define LAS __attribute__((address_space(3)))

constexpr int DM = 2048, NBATCH = 4, SEQ = 2048, CTXL = 256, ML = NBATCH * SEQ, MC = NBATCH * CTXL, MT = ML + MC;
constexpr int FF = 5632, FF2 = 2 * FF, NRIN = 6 * DM, NAIN = 3072, SKV = CTXL + SEQ;
constexpr int NWAVES = 8, NTHR = 512;
constexpr int LDS_BYTES = 144 * 1024, BAR_LDS_OFF = 140 * 1024;
constexpr float EPS = 1e-6f;

constexpr size_t al256(size_t x) { return (x + 255) / 256 * 256; }
constexpr size_t WS_CTL   = 0;
constexpr size_t WS_MOD   = 16384;
constexpr size_t WS_ROPER = WS_MOD + al256((size_t)2 * 5 * 12288 * 4);
constexpr size_t WS_ROPEA = WS_ROPER + (size_t)2 * 2048 * 128 * 4;
constexpr size_t WS_WRIN  = WS_ROPEA + (size_t)2 * 2048 * 64 * 4;
constexpr size_t WS_WROUT = WS_WRIN + (size_t)NRIN * DM * 2;
constexpr size_t WS_WAIN  = WS_WROUT + (size_t)DM * 2 * DM * 2;
constexpr size_t WS_WAOUT = WS_WAIN + (size_t)NAIN * DM * 2;
constexpr size_t WS_WUP   = WS_WAOUT + (size_t)DM * DM * 2;
constexpr size_t WS_WDN   = WS_WUP + (size_t)2 * FF2 * DM * 2;
constexpr size_t WS_XS    = WS_WDN + (size_t)2 * DM * FF * 2;
constexpr size_t WS_H     = WS_XS + (size_t)MT * DM * 4;
constexpr size_t WS_R1    = WS_H + (size_t)MT * DM * 2;
constexpr size_t R1_Q = 0, R1_K = (size_t)MT * DM * 2, R1_V = 2 * R1_K, R1_G = R1_V + (size_t)MT * 4096 * 2, R1_BYTES = R1_G + (size_t)MT * 4096 * 2;
constexpr size_t R1_QN = 0, R1_KN = (size_t)ML * DM * 2, R1_VN = R1_KN + (size_t)NBATCH * SKV * 512 * 2, R1_O = R1_VN + (size_t)NBATCH * SKV * 512 * 2;
constexpr size_t WS_R2    = WS_R1 + R1_BYTES;
constexpr size_t R2_BYTES = (size_t)2 * MT * 4096 * 2;
constexpr size_t WS_END   = WS_R2 + R2_BYTES;
static_assert((size_t)MT * FF2 * 2 <= R1_BYTES, "U fits region 1");
static_assert(R1_O + (size_t)ML * DM * 2 <= R1_BYTES, "layer-1 attention tensors fit region 1");

struct Args { const float* in[20]; float* out; unsigned char* ws; int ph_lo, ph_hi; };
enum { I_X = 0, I_C, I_CTX, I_CCTX, I_ADAW, I_ADAB, I_NORMW, I_RWIN, I_RWOUT, I_RLD, I_RGN, I_AWIN, I_AWOUT, I_AQN, I_AKN, I_FUP, I_FCW, I_FCB, I_FDN, I_FNW };
constexpr int NPH = 20;
#ifndef ONLY_PHASE
#define PHSEL(p) (p)
#else
#define PHSEL(p) ((p) == ONLY_PHASE ? ONLY_PHASE : -1)
#endif

__device__ __forceinline__ float wave_sum(float v) {
#pragma unroll
    for (int o = 1; o < 64; o <<= 1) v += __shfl_xor(v, o);
    return v;
}
__device__ __forceinline__ unsigned pk2(float lo, float hi) { unsigned r; asm volatile("v_cvt_pk_bf16_f32 %0, %1, %2" : "=v"(r) : "v"(lo), "v"(hi)); return r; }
__device__ __forceinline__ float bf2f(unsigned short h) { return __uint_as_float((unsigned)h << 16); }
__device__ __forceinline__ float silu_f(float x) { return x / (1.f + __expf(-x)); }
__device__ __forceinline__ void unpack8(const bf16x8 v, float* f) {
#pragma unroll
    for (int i = 0; i < 8; ++i) f[i] = bf2f((unsigned short)v[i]);
}
__device__ __forceinline__ u32x4 pack8f(const float* f) { u32x4 w; w.x = pk2(f[0], f[1]); w.y = pk2(f[2], f[3]); w.z = pk2(f[4], f[5]); w.w = pk2(f[6], f[7]); return w; }

__device__ __forceinline__ void transpose_item(const float* __restrict__ W, int K, int N, bf16_t* __restrict__ WT, LAS float* scr, int item, int lane) {
    const int nblk = N / 32, kb = item / nblk, nb = item % nblk, k0 = 64 * kb, n0 = 32 * nb;
#pragma unroll 8
    for (int i = 0; i < 32; ++i) { const int kk = 2 * i + (lane >> 5); scr[kk * 33 + (lane & 31)] = W[(size_t)(k0 + kk) * N + n0 + (lane & 31)]; }
    asm volatile("s_waitcnt lgkmcnt(0)" ::: "memory");
    const int c = lane & 7;
#pragma unroll
    for (int j = 0; j < 4; ++j) { const int n = (lane >> 3) + 8 * j; const LAS float* s = scr + (8 * c) * 33 + n;
        u32x4 o; o.x = pk2(s[0 * 33], s[1 * 33]); o.y = pk2(s[2 * 33], s[3 * 33]); o.z = pk2(s[4 * 33], s[5 * 33]); o.w = pk2(s[6 * 33], s[7 * 33]);
        *(u32x4*)(WT + (size_t)(n0 + n) * K + k0 + 8 * c) = o; }
    asm volatile("s_waitcnt lgkmcnt(0)" ::: "memory");
}
__device__ __forceinline__ void phase_prologue(const Args& a, unsigned char* ws, LAS unsigned char* lds, int bid, int G, int tid, int wave, int lane) {
    {
        LAS float* scr = (LAS float*)(lds + wave * 8448);
        const int gw = bid * NWAVES + wave, NGW = G * NWAVES;
        constexpr int I0 = (DM / 64) * (NRIN / 32), I1 = (2 * DM / 64) * (DM / 32), I2 = (DM / 64) * (NAIN / 32), I3 = (DM / 64) * (DM / 32), I4 = (DM / 64) * (FF2 / 32), I5 = (FF / 64) * (DM / 32);
        constexpr int NITEMS = I0 + I1 + I2 + I3 + 2 * I4 + 2 * I5;
        for (int it = gw; it < NITEMS; it += NGW) {
            int r = it;
            if (r < I0) { transpose_item(a.in[I_RWIN], DM, NRIN, (bf16_t*)(ws + WS_WRIN), scr, r, lane); continue; } r -= I0;
            if (r < I1) { transpose_item(a.in[I_RWOUT], 2 * DM, DM, (bf16_t*)(ws + WS_WROUT), scr, r, lane); continue; } r -= I1;
            if (r < I2) { transpose_item(a.in[I_AWIN], DM, NAIN, (bf16_t*)(ws + WS_WAIN), scr, r, lane); continue; } r -= I2;
            if (r < I3) { transpose_item(a.in[I_AWOUT], DM, DM, (bf16_t*)(ws + WS_WAOUT), scr, r, lane); continue; } r -= I3;
            if (r < 2 * I4) { const int l = r / I4; transpose_item(a.in[I_FUP] + (size_t)l * DM * FF2, DM, FF2, (bf16_t*)(ws + WS_WUP) + (size_t)l * FF2 * DM, scr, r - l * I4, lane); continue; } r -= 2 * I4;
            { const int l = r / I5; transpose_item(a.in[I_FDN] + (size_t)l * FF * DM, FF, DM, (bf16_t*)(ws + WS_WDN) + (size_t)l * DM * FF, scr, r - l * I5, lane); }
        }
    }
    __syncthreads();
    {
        LAS float* act = (LAS float*)lds;
        LAS float* red = (LAS float*)(lds + 40960);
        for (int i = tid; i < 5 * DM; i += NTHR) { const int r = i / DM, k = i % DM; const float v = r < 4 ? a.in[I_C][r * DM + k] : a.in[I_CCTX][k]; act[i] = silu_f(v); }
        __syncthreads();
        const int c4 = tid & 15, ks = tid >> 4;
        for (int it = bid; it < 2 * 192; it += G) {
            const int l = it / 192, c0 = (it % 192) * 64;
            f32x4 acc[5];
#pragma unroll
            for (int r = 0; r < 5; ++r) acc[r] = (f32x4){0.f, 0.f, 0.f, 0.f};
            const float* wp = a.in[I_ADAW] + (size_t)l * DM * 12288 + (size_t)(ks * 64) * 12288 + c0 + c4 * 4;
#pragma unroll 8
            for (int kk = 0; kk < 64; ++kk) { const f32x4 w = *(const f32x4*)(wp + (size_t)kk * 12288);
#pragma unroll
                for (int r = 0; r < 5; ++r) acc[r] += act[r * DM + ks * 64 + kk] * w; }
#pragma unroll
            for (int r = 0; r < 5; ++r) *(LAS f32x4*)(red + (ks * 5 + r) * 64 + c4 * 4) = acc[r];
            __syncthreads();
            if (tid < 320) { const int r = tid >> 6, c = tid & 63; float s = 0.f;
                for (int k2 = 0; k2 < 32; ++k2) s += red[(k2 * 5 + r) * 64 + c];
                ((float*)(ws + WS_MOD))[(size_t)(l * 5 + r) * 12288 + c0 + c] = s + a.in[I_ADAB][l * 12288 + c0 + c]; }
            __syncthreads();
        }
    }
    {
        float* cr = (float*)(ws + WS_ROPER); float* sr = cr + 2048 * 128; float* ca = (float*)(ws + WS_ROPEA); float* sa = ca + 2048 * 64;
        const int gt = bid * NTHR + tid, NT = G * NTHR;
        for (int idx = gt; idx < 2048 * 128; idx += NT) { const int t = idx >> 7, i = idx & 127, f = i & 63; const int pos = (i < 64) ? (t >> 6) : (t & 63);
            const float inv = powf(10000.f, -(float)f / 64.f), ang = (float)pos * inv; float s, c; sincosf(ang, &s, &c); cr[idx] = c; sr[idx] = s; }
        for (int idx = gt; idx < 2048 * 64; idx += NT) { const int t = idx >> 6, i = idx & 63, f = i & 31; const int pos = (i < 32) ? (t >> 6) : (t & 63);
            const float inv = powf(10000.f, -(float)f / 32.f), ang = (float)pos * inv; float s, c; sincosf(ang, &s, &c); ca[idx] = c; sa[idx] = s; }
    }
}

__device__ __forceinline__ void phase_norm(const float* srcX, const float* srcC, const float* nw, const float* mod  , int shoff, bf16_t* H, int nrows, int bid, int G, int wave, int lane) {
    const int gw = bid * NWAVES + wave, NGW = G * NWAVES;
    for (int row = gw; row < nrows; row += NGW) {
        const float* src = row < ML ? srcX + (size_t)row * DM : srcC + (size_t)(row - ML) * DM;
        const int mr = row < ML ? (row >> 11) : 4;
        const float* sh = mod + mr * 12288 + shoff; const float* sc = sh + DM;
        f32x4 v[8]; float ss = 0.f;
#pragma unroll
        for (int j = 0; j < 8; ++j) { v[j] = *(const f32x4*)(src + (lane + 64 * j) * 4); ss += (v[j][0] * v[j][0] + v[j][1] * v[j][1]) + (v[j][2] * v[j][2] + v[j][3] * v[j][3]); }
        const float rstd = 1.0f / sqrtf(wave_sum(ss) * (1.f / DM) + EPS);
#pragma unroll
        for (int j = 0; j < 8; ++j) { const int c = (lane + 64 * j) * 4;
            const f32x4 w = *(const f32x4*)(nw + c), s1 = *(const f32x4*)(sc + c), s0 = *(const f32x4*)(sh + c);
            const f32x4 h = (v[j] * rstd) * w * (1.f + s1) + s0;
            u32x2 o; o.x = pk2(h[0], h[1]); o.y = pk2(h[2], h[3]); *(u32x2*)(H + (size_t)row * DM + c) = o; }
    }
}
__device__ __forceinline__ void phase_final(const float* XS, const float* nw, float* out, int bid, int G, int wave, int lane) {
    const int gw = bid * NWAVES + wave, NGW = G * NWAVES;
    for (int row = gw; row < ML; row += NGW) {
        const float* src = XS + (size_t)row * DM;
        f32x4 v[8]; float ss = 0.f;
#pragma unroll
        for (int j = 0; j < 8; ++j) { v[j] = *(const f32x4*)(src + (lane + 64 * j) * 4); ss += (v[j][0] * v[j][0] + v[j][1] * v[j][1]) + (v[j][2] * v[j][2] + v[j][3] * v[j][3]); }
        const float rstd = 1.0f / sqrtf(wave_sum(ss) * (1.f / DM) + EPS);
#pragma unroll
        for (int j = 0; j < 8; ++j) { const int c = (lane + 64 * j) * 4; const f32x4 w = *(const f32x4*)(nw + c); *(f32x4*)(out + (size_t)row * DM + c) = (v[j] * rstd) * w; }
    }
}

constexpr int RP = 136;
constexpr int RT_BYTES = 128 * RP * 2;
__device__ __forceinline__ bf16x8 ret_trfrag(const LAS bf16_t* T, int k0, int c0, int lane) {
    const int i = lane & 15, g = lane >> 4, q = i >> 2, p = i & 3;
    const LAS bf16_t* a1 = T + (k0 + 8 * g + q) * RP + c0 + 4 * p;
    const s16x4 lo = __builtin_amdgcn_ds_read_tr16_b64_v4i16((LAS s16x4*)a1);
    const s16x4 hi = __builtin_amdgcn_ds_read_tr16_b64_v4i16((LAS s16x4*)(a1 + 4 * RP));
    return (bf16x8){lo[0], lo[1], lo[2], lo[3], hi[0], hi[1], hi[2], hi[3]};
}
__device__ __forceinline__ void ret_load_tile(LAS bf16_t* dst, const bf16_t* src, int ld, int tid) {
#pragma unroll
    for (int i = 0; i < 4; ++i) { const int id = tid + NTHR * i, row = id >> 4, cc = id & 15;
        *(LAS bf16x8*)(dst + row * RP + cc * 8) = *(const bf16x8*)(src + (size_t)row * ld + cc * 8); }
}
__device__ __forceinline__ void phase_retention(const bf16_t* Qb, const bf16_t* Kb, const bf16_t* Vb, bf16_t* OD, const float* logdecay, LAS unsigned char* lds, int bid, int G, int tid, int wave, int lane) {
    LAS bf16_t* QH = (LAS bf16_t*)lds; LAS bf16_t* KH = (LAS bf16_t*)(lds + RT_BYTES); LAS bf16_t* VV = (LAS bf16_t*)(lds + 2 * RT_BYTES); LAS bf16_t* PP = (LAS bf16_t*)(lds + 3 * RT_BYTES);
    const int ew = 16 * wave;
    const int qt0 = 2 * (wave >> 1), kt0 = 4 * (wave & 1);
    for (int u = bid; u < 256; u += G) {
        const int es = u & 3, dir = (u >> 2) & 1, h = (u >> 3) & 7, b = u >> 6, e0 = es * 128;
        const float lg2u = -expf(logdecay[dir * 8 + h]) * 1.4426950408889634f;
        f32x4 S[16];
#pragma unroll
        for (int i = 0; i < 16; ++i) S[i] = (f32x4){0.f, 0.f, 0.f, 0.f};
        for (int s = 0; s < 18; ++s) {
            int tid_o = tid; asm volatile("" : "+v"(tid_o)); const int lane_o = tid_o & 63, fr = lane_o & 15, g = lane_o >> 4;
            float lg2 = lg2u; asm volatile("" : "+v"(lg2));
            const bool isctx = s < 2;
            const int ci = dir == 0 ? (isctx ? s : s - 2) : (isctx ? 1 - s : 17 - s);
            const int row0 = isctx ? ML + b * CTXL + ci * 128 : b * SEQ + ci * 128;
            ret_load_tile(VV, Vb + (size_t)row0 * 4096 + h * 512 + e0, 4096, tid_o);
            ret_load_tile(QH, Qb + (size_t)row0 * 2048 + h * 256, 2048, tid_o);
            ret_load_tile(KH, Kb + (size_t)row0 * 2048 + h * 256, 2048, tid_o);
            __syncthreads();
            f32x4 sc[2][4], oi[8];
#pragma unroll
            for (int i = 0; i < 2; ++i)
#pragma unroll
                for (int j = 0; j < 4; ++j) sc[i][j] = (f32x4){0.f, 0.f, 0.f, 0.f};
#pragma unroll
            for (int i = 0; i < 8; ++i) oi[i] = (f32x4){0.f, 0.f, 0.f, 0.f};
#pragma unroll
            for (int hh = 0; hh < 2; ++hh) {
                if (hh == 1) {
                    __syncthreads();
                    ret_load_tile(QH, Qb + (size_t)row0 * 2048 + h * 256 + 128, 2048, tid_o);
                    ret_load_tile(KH, Kb + (size_t)row0 * 2048 + h * 256 + 128, 2048, tid_o);
                    __syncthreads();
                }
#pragma unroll
                for (int ks = 0; ks < 4; ++ks) {
                    bf16x8 qf[2], kf[4];
#pragma unroll
                    for (int a = 0; a < 2; ++a) qf[a] = *(const LAS bf16x8*)(QH + (16 * (qt0 + a) + fr) * RP + ks * 32 + 8 * g);
#pragma unroll
                    for (int c = 0; c < 4; ++c) kf[c] = *(const LAS bf16x8*)(KH + (16 * (kt0 + c) + fr) * RP + ks * 32 + 8 * g);
#pragma unroll
                    for (int a = 0; a < 2; ++a)
#pragma unroll
                        for (int c = 0; c < 4; ++c) sc[a][c] = __builtin_amdgcn_mfma_f32_16x16x32_bf16(kf[c], qf[a], sc[a][c], 0, 0, 0);
                    __builtin_amdgcn_sched_barrier(0);
                }
#pragma unroll
                for (int p = 0; p < 4; ++p) {
                    const f32x4 sa = S[8 * hh + 2 * p], sb = S[8 * hh + 2 * p + 1];
                    u32x4 bw; bw.x = pk2(sa[0], sa[1]); bw.y = pk2(sa[2], sa[3]); bw.z = pk2(sb[0], sb[1]); bw.w = pk2(sb[2], sb[3]);
                    const bf16x8 bfrag = __builtin_bit_cast(bf16x8, bw);
#pragma unroll
                    for (int nt = 0; nt < 8; ++nt) {
                        const LAS bf16_t* qa = QH + (16 * nt + fr) * RP + 32 * p + 4 * g;
                        const s16x4 lo = *(const LAS s16x4*)qa, hi = *(const LAS s16x4*)(qa + 16);
                        const bf16x8 afrag = (bf16x8){lo[0], lo[1], lo[2], lo[3], hi[0], hi[1], hi[2], hi[3]};
                        oi[nt] = __builtin_amdgcn_mfma_f32_16x16x32_bf16(afrag, bfrag, oi[nt], 0, 0, 0);
                    }
                    __builtin_amdgcn_sched_barrier(0);
                }
                { const float cd = __builtin_amdgcn_exp2f(lg2 * 128.f);
#pragma unroll
                for (int j = 0; j < 8; ++j) S[8 * hh + j] = S[8 * hh + j] * cd; }
#pragma unroll
                for (int ks = 0; ks < 4; ++ks) {
                    bf16x8 vf = ret_trfrag(VV, 32 * ks, ew, lane_o);
                    { float f[8]; unpack8(vf, f);
#pragma unroll
                      for (int jj = 0; jj < 8; ++jj) { const int m = 32 * ks + 8 * g + jj; f[jj] *= __builtin_amdgcn_exp2f(lg2 * (float)(dir == 0 ? 127 - m : m)); }
                      vf = __builtin_bit_cast(bf16x8, pack8f(f)); }
#pragma unroll
                    for (int j = 0; j < 8; ++j) { const bf16x8 kT = ret_trfrag(KH, 32 * ks, 16 * j, lane_o);
                        S[8 * hh + j] = __builtin_amdgcn_mfma_f32_16x16x32_bf16(kT, vf, S[8 * hh + j], 0, 0, 0); }
                    __builtin_amdgcn_sched_barrier(0);
                }
            }
#pragma unroll
            for (int a = 0; a < 2; ++a)
#pragma unroll
                for (int c = 0; c < 4; ++c) { const int n = 16 * (qt0 + a) + fr, m0 = 16 * (kt0 + c) + 4 * g; float pv[4];
#pragma unroll
                    for (int r = 0; r < 4; ++r) { const int m = m0 + r; const int dd = dir == 0 ? n - m : m - n; pv[r] = dd >= 0 ? sc[a][c][r] * __builtin_amdgcn_exp2f(lg2 * (float)dd) : 0.f; }
                    u32x2 w; w.x = pk2(pv[0], pv[1]); w.y = pk2(pv[2], pv[3]); *(LAS u32x2*)(PP + n * RP + m0) = w; }
            __syncthreads();
#pragma unroll
            for (int nt = 0; nt < 8; ++nt)
#pragma unroll
                for (int r = 0; r < 4; ++r) { const int n = 16 * nt + 4 * g + r; oi[nt][r] *= __builtin_amdgcn_exp2f(lg2 * (float)(dir == 0 ? n + 1 : 128 - n)); }
#pragma unroll
            for (int ks = 0; ks < 4; ++ks) { const bf16x8 vf = ret_trfrag(VV, 32 * ks, ew, lane_o);
#pragma unroll
                for (int nt = 0; nt < 8; ++nt) { const bf16x8 pf = *(const LAS bf16x8*)(PP + (16 * nt + fr) * RP + 32 * ks + 8 * g);
                    oi[nt] = __builtin_amdgcn_mfma_f32_16x16x32_bf16(pf, vf, oi[nt], 0, 0, 0); }
                __builtin_amdgcn_sched_barrier(0); }
            bf16_t* op = OD + (size_t)dir * MT * 4096 + (size_t)row0 * 4096 + h * 512 + e0 + ew + fr;
#pragma unroll
            for (int nt = 0; nt < 8; ++nt)
#pragma unroll
                for (int r = 0; r < 4; ++r) op[(size_t)(16 * nt + 4 * g + r) * 4096] = (bf16_t)(pk2(oi[nt][r], 0.f) & 0xffffu);
            __syncthreads();
        }
    }
}
__device__ __forceinline__ void phase_combine(const bf16_t* OD, const bf16_t* Gb, const float* gnw, bf16_t* Y, int bid, int G, int wave, int lane) {
    const int gw = bid * NWAVES + wave, NGW = G * NWAVES;
    for (int it = gw; it < MT * 8; it += NGW) {
        const int row = it >> 3, h = it & 7; const size_t off = (size_t)row * 4096 + h * 512 + lane * 8;
        float a[8], b2[8], gg[8];
        unpack8(*(const bf16x8*)(OD + off), a); unpack8(*(const bf16x8*)(OD + (size_t)MT * 4096 + off), b2); unpack8(*(const bf16x8*)(Gb + off), gg);
        float s = 0.f;
#pragma unroll
        for (int i = 0; i < 8; ++i) { a[i] += b2[i]; s += a[i]; }
        const float mu = wave_sum(s) * (1.f / 512.f); float q = 0.f;
#pragma unroll
        for (int i = 0; i < 8; ++i) { a[i] -= mu; q += a[i] * a[i]; }
        const float rstd = 1.0f / sqrtf(wave_sum(q) * (1.f / 512.f) + EPS);
        const f32x4 w0 = *(const f32x4*)(gnw + h * 512 + lane * 8), w1 = *(const f32x4*)(gnw + h * 512 + lane * 8 + 4);
        float o[8];
#pragma unroll
        for (int i = 0; i < 8; ++i) o[i] = a[i] * rstd * (i < 4 ? w0[i] : w1[i - 4]) * silu_f(gg[i]);
        *(u32x4*)(Y + off) = pack8f(o);
    }
}
__device__ __forceinline__ void phase_conv(const bf16_t* U, const float* cw, const float* cb, bf16_t* ACT, int nrows, int bid, int G, int tid) {
    const long gt = (long)bid * NTHR + tid, NT = (long)G * NTHR, total = (long)nrows * (FF / 8);
    for (long idx = gt; idx < total; idx += NT) {
        const int row = (int)(idx / (FF / 8)), f0 = (int)(idx % (FF / 8)) * 8;
        int t, len; if (row < ML) { t = row & (SEQ - 1); len = SEQ; } else { t = (row - ML) & (CTXL - 1); len = CTXL; }
        float xa[8], xb[8];
#pragma unroll
        for (int i = 0; i < 8; ++i) { xa[i] = cb[f0 + i]; xb[i] = cb[FF + f0 + i]; }
#pragma unroll
        for (int j = 0; j < 3; ++j) { const int tt = t + j - 1;
            if (tt >= 0 && tt < len) { float ua[8], ub[8]; const bf16_t* up = U + (size_t)(row + j - 1) * FF2 + f0;
                unpack8(*(const bf16x8*)up, ua); unpack8(*(const bf16x8*)(up + FF), ub);
                const float* wa = cw + j * FF2 + f0;
#pragma unroll
                for (int i = 0; i < 8; ++i) { xa[i] += ua[i] * wa[i]; xb[i] += ub[i] * wa[FF + i]; } } }
        float o[8];
#pragma unroll
        for (int i = 0; i < 8; ++i) o[i] = silu_f(xa[i]) * xb[i];
        *(u32x4*)(ACT + (size_t)row * FF + f0) = pack8f(o);
    }
}
__device__ __forceinline__ void phase_qknorm(const bf16_t* QKV, const float* qn, const float* kn, const float* cosa, const float* sina, bf16_t* Qn, bf16_t* Kn, bf16_t* Vn, int bid, int G, int wave, int lane) {
    const int gw = bid * NWAVES + wave, NGW = G * NWAVES;
    for (int it = gw; it < MT * 6; it += NGW) {
        const int row = it / 6, sg = it % 6, s = sg * 4 + (lane >> 4), i = lane & 15, d0 = 8 * i;
        float x[8]; unpack8(*(const bf16x8*)(QKV + (size_t)row * NAIN + s * 128 + d0), x);
        float ss = 0.f;
#pragma unroll
        for (int j = 0; j < 8; ++j) ss += x[j] * x[j];
        ss += __shfl_xor(ss, 1); ss += __shfl_xor(ss, 2); ss += __shfl_xor(ss, 4); ss += __shfl_xor(ss, 8);
        const bool latent = row < ML;
        if (s < 20) {
            const float rstd = 1.0f / sqrtf(ss * (1.f / 128.f) + EPS); const float* nw = (s < 16 ? qn : kn) + d0;
#pragma unroll
            for (int j = 0; j < 8; ++j) x[j] = x[j] * rstd * nw[j];
            if (latent) { const int t = row & (SEQ - 1); const f32x4 cs = *(const f32x4*)(cosa + t * 64 + 4 * i), sn = *(const f32x4*)(sina + t * 64 + 4 * i);
#pragma unroll
                for (int p = 0; p < 4; ++p) { const float x1 = x[2 * p], x2 = x[2 * p + 1]; x[2 * p] = x1 * cs[p] - x2 * sn[p]; x[2 * p + 1] = x1 * sn[p] + x2 * cs[p]; } }
        }
        const u32x4 o = pack8f(x);
        if (s < 16) { if (latent) *(u32x4*)(Qn + (size_t)row * DM + s * 128 + d0) = o; }
        else { const int b = latent ? (row >> 11) : ((row - ML) >> 8), key = latent ? CTXL + (row & (SEQ - 1)) : ((row - ML) & (CTXL - 1));
            bf16_t* dst = (s < 20 ? Kn : Vn) + ((size_t)b * SKV + key) * 512 + (s & 3) * 128 + d0; *(u32x4*)dst = o; }
    }
}
__device__ __forceinline__ void phase_attention(const bf16_t* Qn, const bf16_t* Kn, const bf16_t* Vn, bf16_t* O, unsigned char* lds_generic, int bid, int G, int tid) {
    for (int u = bid; u < 512; u += G) {
        const int grp = (u & 7) * 2 + (u >> 8), slot = (u >> 3) & 31, b = grp >> 2, kvh = grp & 3, h = kvh * 4 + (slot >> 3), qb = slot & 7;
        const size_t qoff = ((size_t)b * SEQ + qb * 256) * DM + h * 128, koff = (size_t)b * SKV * 512 + kvh * 128;
        att::attn_dense_body((const att::bf16*)(Qn + qoff), (const att::bf16*)(Kn + koff), (const att::bf16*)(Vn + koff), (att::bf16*)(O + qoff), SKV, (char*)lds_generic, tid);
        __syncthreads();
    }
}

#define XB_TMO      128
#define XB_XCNT(j)  (256  + 64 * (j))
#define XB_XSUB(j)  (1280 + 64 * (j))
#define XB_XGEN(j)  (2304 + 64 * (j))
#define XB_TOP      3328
#define XB_TOPGEN   3392
#define XCD_BAR_WORDS 3456
#define XB_XSUB(j)  (1280 + 64 * (j))
#define XB_XGEN(j)  (2304 + 64 * (j))
#define XB_TOP      3328
#define XB_TOPGEN   3392
#define XCD_BAR_WORDS 3456
#define XB_SPIN_CAP (1u << 18)

__device__ __forceinline__ unsigned xb_ld(unsigned* p)              { return __hip_atomic_load(p, __ATOMIC_RELAXED, __HIP_MEMORY_SCOPE_AGENT); }
__device__ __forceinline__ unsigned xb_add(unsigned* p, unsigned v) { return __hip_atomic_fetch_add(p, v, __ATOMIC_RELAXED, __HIP_MEMORY_SCOPE_AGENT); }
__device__ __forceinline__ unsigned xb_xcc_id() { return (unsigned)__builtin_amdgcn_s_getreg((3 << 11) | 20) & 0xFu; }
#define XB_SPIN(cond, bar) do { unsigned _sp = 0; while (cond) { __builtin_amdgcn_s_sleep(1); \
    if ((++_sp & 255u) == 0u) { if (xb_ld(&(bar)[XB_TMO])) break; if (_sp > XB_SPIN_CAP) { atomicAdd(&(bar)[XB_TMO], 1u); break; } } } } while (0)

struct XcdBarrier {
    unsigned* bar; unsigned x;
    volatile LAS unsigned* st;
};

__device__ __forceinline__ XcdBarrier xcd_barrier_post(unsigned* bar, volatile LAS unsigned* st) {
    XcdBarrier b; b.bar = bar; b.x = xb_xcc_id(); b.st = st;
    if (threadIdx.x == 0) (void)xb_add(&bar[XB_XCNT(b.x)], 1u);
    return b;
}
__device__ __forceinline__ void xcd_barrier_complete(unsigned* bar, unsigned x, unsigned& nloc, unsigned& nx) {
    const unsigned G = gridDim.x * gridDim.y * gridDim.z;
    unsigned sum, cnt, mine, sp = 0u;
    for (;;) {
        sum = 0u; cnt = 0u; mine = 0u;
#pragma unroll
        for (unsigned j = 0; j < 16; ++j) { const unsigned c = xb_ld(&bar[XB_XCNT(j)]); sum += c; cnt += (c > 0u) ? 1u : 0u; mine = (j == x) ? c : mine; }
        if (sum == G) break;
        __builtin_amdgcn_s_sleep(1);
        if ((++sp & 255u) == 0u) { if (xb_ld(&bar[XB_TMO])) break; if (sp > XB_SPIN_CAP) { atomicAdd(&bar[XB_TMO], 1u); break; } }
    }
    nloc = mine > 0u ? mine : 1u; nx = cnt > 0u ? cnt : 1u;
}

__device__ __forceinline__ void xcd_barrier(const XcdBarrier& b) {
    asm volatile("s_waitcnt vmcnt(0)" ::: "memory");
    __syncthreads();
    if (threadIdx.x == 0) {
        unsigned* bar = b.bar;
        __builtin_amdgcn_s_waitcnt(0);
        unsigned nloc = b.st[0], nx = b.st[1];
        if (nloc == 0u) { xcd_barrier_complete(bar, b.x, nloc, nx); b.st[0] = nloc; b.st[1] = nx; }
        const unsigned old = xb_add(&bar[XB_XSUB(b.x)], 1u);
        const unsigned gen = old / nloc;
        if (old + 1u == (gen + 1u) * nloc) {
            __builtin_amdgcn_fence(__ATOMIC_RELEASE, "agent");
            asm volatile("s_waitcnt vmcnt(0)" ::: "memory");
            const unsigned og = xb_add(&bar[XB_TOP], 1u);
            const unsigned tg = og / nx;
            if (og + 1u == (tg + 1u) * nx) xb_add(&bar[XB_TOPGEN], 1u);
            else XB_SPIN(xb_ld(&bar[XB_TOPGEN]) == tg, bar);
            __builtin_amdgcn_fence(__ATOMIC_ACQUIRE, "agent");
            xb_add(&bar[XB_XGEN(b.x)], 1u);
            asm volatile("s_waitcnt vmcnt(0)" ::: "memory");
        } else {
            XB_SPIN(xb_ld(&bar[XB_XGEN(b.x)]) == gen, bar);
            __builtin_amdgcn_fence(__ATOMIC_ACQUIRE, "agent");
            asm volatile("s_waitcnt vmcnt(0)" ::: "memory");
        }
    }
    __syncthreads();
}

__global__ void __launch_bounds__(NTHR, 2) mega(Args a) {
    extern __shared__ __attribute__((aligned(16))) unsigned char lds_raw[];
    LAS unsigned char* lds = (LAS unsigned char*)lds_raw;
    cg::grid_group grid = cg::this_grid();
    const int bid = blockIdx.x, G = gridDim.x;
    unsigned char* ws = a.ws;
    const float* MOD = (const float*)(ws + WS_MOD);
    float* XS = (float*)(ws + WS_XS); bf16_t* H = (bf16_t*)(ws + WS_H);
    unsigned char* R1 = ws + WS_R1; unsigned char* R2 = ws + WS_R2;
    volatile LAS unsigned* bst = (volatile LAS unsigned*)(lds + BAR_LDS_OFF);
    if (threadIdx.x < 2) bst[threadIdx.x] = 0u;
    __syncthreads();
    XcdBarrier xbar; xbar.bar = (unsigned*)(ws + WS_CTL); xbar.x = 0; xbar.st = nullptr;
    if (a.ph_hi - a.ph_lo > 1) xbar = xcd_barrier_post((unsigned*)(ws + WS_CTL), bst);
    auto run = [&](auto PC) {
        constexpr int p = decltype(PC)::value;
        int tid = threadIdx.x; asm volatile("" : "+v"(tid));
        const int lane = tid & 63, wave = __builtin_amdgcn_readfirstlane(tid >> 6);
        const int layer = p >= 10 ? 1 : 0;
        const float* mod = MOD + (size_t)layer * 5 * 12288;
        switch (PHSEL(p)) {
        case 0: phase_prologue(a, ws, lds, bid, G, tid, wave, lane); break;
        case 1: phase_norm(a.in[I_X], a.in[I_CTX], a.in[I_NORMW] + 0 * DM, mod, 0, H, MT, bid, G, wave, lane); break;
        case 6: phase_norm(XS, XS + (size_t)ML * DM, a.in[I_NORMW] + 1 * DM, mod, 3 * DM, H, MT, bid, G, wave, lane); break;
        case 10: phase_norm(XS, XS + (size_t)ML * DM, a.in[I_NORMW] + 2 * DM, mod, 0, H, MT, bid, G, wave, lane); break;
        case 15: phase_norm(XS, XS + (size_t)ML * DM, a.in[I_NORMW] + 3 * DM, mod, 3 * DM, H, ML, bid, G, wave, lane); break;
        case 2: {
            pg8::Gemm g{H, (const bf16_t*)(ws + WS_WRIN), MT, NRIN, DM}; pg8::StaticOrder S; S.init(MT, NRIN, G, bid);
            pg8::EpiRow8<pg8::FRope> E{{(bf16_t*)(R1 + R1_Q), (bf16_t*)(R1 + R1_K), (bf16_t*)(R1 + R1_V), (bf16_t*)(R1 + R1_G), (const float*)(ws + WS_ROPER), (const float*)(ws + WS_ROPER) + 2048 * 128, ML}};
            pg8::gemm_phase<pg8::EpiRow8<pg8::FRope>, pg8::StaticOrder, true, true>(lds, g, S, E, tid);
        } break;
        case 3: phase_retention((const bf16_t*)(R1 + R1_Q), (const bf16_t*)(R1 + R1_K), (const bf16_t*)(R1 + R1_V), (bf16_t*)R2, a.in[I_RLD], lds, bid, G, tid, wave, lane); break;
        case 4: phase_combine((const bf16_t*)R2, (const bf16_t*)(R1 + R1_G), a.in[I_RGN], (bf16_t*)(R1 + R1_V), bid, G, wave, lane); break;
        case 5: case 9: case 14: case 18: {
            const bf16_t* A; const bf16_t* Bt; int M, K; const float* bx; const float* bc; int goff;
            if (p == 5)       { A = (const bf16_t*)(R1 + R1_V); Bt = (const bf16_t*)(ws + WS_WROUT); M = MT; K = 2 * DM; bx = a.in[I_X]; bc = a.in[I_CTX]; goff = 2 * DM; }
            else if (p == 9)  { A = (const bf16_t*)R2; Bt = (const bf16_t*)(ws + WS_WDN); M = MT; K = FF; bx = XS; bc = XS + (size_t)ML * DM; goff = 5 * DM; }
            else if (p == 14) { A = (const bf16_t*)(R1 + R1_O); Bt = (const bf16_t*)(ws + WS_WAOUT); M = ML; K = DM; bx = XS; bc = XS + (size_t)ML * DM; goff = 2 * DM; }
            else              { A = (const bf16_t*)R2; Bt = (const bf16_t*)(ws + WS_WDN) + (size_t)DM * FF; M = ML; K = FF; bx = XS; bc = XS + (size_t)ML * DM; goff = 5 * DM; }
            pg8::Gemm g{A, Bt, M, DM, K}; pg8::StaticOrder S; S.init(M, DM, G, bid);
            pg8::EpiRow8<pg8::FRes> E{{bx, bc, XS, mod + goff, ML}};
            pg8::gemm_phase<pg8::EpiRow8<pg8::FRes>, pg8::StaticOrder, true, true>(lds, g, S, E, tid);
        } break;
        case 7: case 11: case 16: {
            const bf16_t* Bt; int M, N; bf16_t* O;
            if (p == 7)       { Bt = (const bf16_t*)(ws + WS_WUP); M = MT; N = FF2; O = (bf16_t*)R1; }
            else if (p == 11) { Bt = (const bf16_t*)(ws + WS_WAIN); M = MT; N = NAIN; O = (bf16_t*)R2; }
            else              { Bt = (const bf16_t*)(ws + WS_WUP) + (size_t)FF2 * DM; M = ML; N = FF2; O = (bf16_t*)R1; }
            pg8::Gemm g{H, Bt, M, N, DM}; pg8::StaticOrder S; S.init(M, N, G, bid);
            pg8::EpiRow8<pg8::FPlain> E{{O, N}};
            pg8::gemm_phase<pg8::EpiRow8<pg8::FPlain>, pg8::StaticOrder, true, true>(lds, g, S, E, tid);
        } break;
        case 8: phase_conv((const bf16_t*)R1, a.in[I_FCW], a.in[I_FCB], (bf16_t*)R2, MT, bid, G, tid); break;
        case 17: phase_conv((const bf16_t*)R1, a.in[I_FCW] + 3 * FF2, a.in[I_FCB] + FF2, (bf16_t*)R2, ML, bid, G, tid); break;
        case 12: phase_qknorm((const bf16_t*)R2, a.in[I_AQN], a.in[I_AKN], (const float*)(ws + WS_ROPEA), (const float*)(ws + WS_ROPEA) + 2048 * 64,
                              (bf16_t*)(R1 + R1_QN), (bf16_t*)(R1 + R1_KN), (bf16_t*)(R1 + R1_VN), bid, G, wave, lane); break;
        case 13: phase_attention((const bf16_t*)(R1 + R1_QN), (const bf16_t*)(R1 + R1_KN), (const bf16_t*)(R1 + R1_VN), (bf16_t*)(R1 + R1_O), lds_raw, bid, G, tid); break;
        case 19: phase_final(XS, a.in[I_FNW], a.out, bid, G, wave, lane); break;
        default: break;
        }
    };
    unsigned long long tp0 = 0, tp1 = 0;
#define RUNP(P) if (a.ph_lo <= (P) && (P) < a.ph_hi) { if ((P) == TIME_PHASE) tp0 = __builtin_amdgcn_s_memrealtime(); run(std::integral_constant<int, (P)>{}); if ((P) + 1 < a.ph_hi) { if (USE_CG_SYNC) grid.sync(); else xcd_barrier(xbar); } if ((P) == TIME_PHASE) tp1 = __builtin_amdgcn_s_memrealtime(); }
    RUNP(0) RUNP(1) RUNP(2) RUNP(3) RUNP(4) RUNP(5) RUNP(6) RUNP(7) RUNP(8) RUNP(9) RUNP(10) RUNP(11) RUNP(12) RUNP(13) RUNP(14) RUNP(15) RUNP(16) RUNP(17) RUNP(18) RUNP(19)
#undef RUNP
    if (TIME_PHASE >= 0 && bid == 0 && threadIdx.x == 0) { const unsigned long long tgt = (tp1 - tp0) * TIME_SCALE, ts = __builtin_amdgcn_s_memrealtime(); while (__builtin_amdgcn_s_memrealtime() - ts < tgt) __builtin_amdgcn_s_sleep(32); }
}

extern "C" void kernel_launch(void* const* d_in, const int* in_sizes, int n_in, void* d_out, int out_size, void* d_ws, size_t ws_size, hipStream_t stream) {
    static int grid = 0;
    if (grid == 0) {
        if (n_in != 20 || out_size != ML * DM || ws_size < WS_END) { fprintf(stderr, "kernel_launch: unexpected shapes: n_in %d out %d ws %zu (need %zu)\n", n_in, out_size, ws_size, (size_t)WS_END); grid = -1; return; }
        int dev = 0, cus = 0, per_cu = 0;
        hipGetDevice(&dev); hipDeviceGetAttribute(&cus, hipDeviceAttributeMultiprocessorCount, dev);
        if (hipFuncSetAttribute((const void*)mega, hipFuncAttributeMaxDynamicSharedMemorySize, LDS_BYTES) != hipSuccess) { fprintf(stderr, "kernel_launch: hipFuncSetAttribute failed\n"); grid = -1; return; }
        hipOccupancyMaxActiveBlocksPerMultiprocessor(&per_cu, (const void*)mega, NTHR, LDS_BYTES);
        if (per_cu < 1) { fprintf(stderr, "kernel_launch: occupancy query says %d blocks per CU\n", per_cu); per_cu = 1; }
        (void)hipGetLastError();
        grid = cus * 1;
        fprintf(stderr, "kernel_launch: grid %d (cus %d, per_cu %d), ws %zu need %zu\n", grid, cus, per_cu, ws_size, (size_t)WS_END);
    }
    if (grid < 0) return;
    Args a{};
    for (int i = 0; i < 20; ++i) a.in[i] = (const float*)d_in[i];
    a.out = (float*)d_out; a.ws = (unsigned char*)d_ws;
#if ONE_LAUNCH
    if (hipMemsetAsync((char*)d_ws + WS_CTL, 0, 16384, stream) != hipSuccess) { fprintf(stderr, "kernel_launch: memset failed\n"); return; }
    a.ph_lo = 0; a.ph_hi = NPH;
    void* args[] = {&a};
    hipError_t e = hipLaunchCooperativeKernel((const void*)mega, dim3(grid), dim3(NTHR), args, LDS_BYTES, stream);
    if (e != hipSuccess) fprintf(stderr, "kernel_launch: cooperative launch failed: %s (grid %d)\n", hipGetErrorString(e), grid);
#else
    for (int p = 0; p < NPH; ++p) { a.ph_lo = p; a.ph_hi = p + 1; hipLaunchKernelGGL(mega, dim3(grid), dim3(NTHR), LDS_BYTES, stream, a); }
    const hipError_t le = hipPeekAtLastError();
    if (le != hipSuccess) fprintf(stderr, "kernel_launch: launch failed: %s\n", hipGetErrorName(le));
#endif
}
```

```cpp
#include <hip/hip_runtime.h>
#include <hip/hip_bf16.h>
#include <hip/hip_cooperative_groups.h>
#include <cstdio>
#include <cstdint>
#include <cmath>
#include <type_traits>
namespace cg = cooperative_groups;
#ifndef ONE_LAUNCH
#define ONE_LAUNCH 1
#endif
#ifndef TIME_PHASE
#define TIME_PHASE -1
#endif
#define TIME_SCALE 4
#ifndef USE_CG_SYNC
#define USE_CG_SYNC 0
#endif
namespace pg8 {
#define PG8_LAS __attribute__((address_space(3)))
typedef unsigned short bf16_t;
typedef short bf16x8 __attribute__((ext_vector_type(8)));
typedef float f32x4 __attribute__((ext_vector_type(4)));
typedef unsigned u32x4 __attribute__((ext_vector_type(4)));
constexpr int BM = 256, BK = 64, HALF = 128, HTB = HALF * BK * 2  , STAGE_BYTES = 8 * HTB, NXCD = 8, WGM = 8;

__host__ __device__ __forceinline__ int lds_byte(int r, int c) { const int st = (r >> 4) * 2 + (c >> 5), rr = r & 15, cc = c & 31, ob = rr * 64 + cc * 2; return st * 1024 + (ob ^ (((ob >> 9) & 1) << 5)); }
__host__ __device__ __forceinline__ void stage_rc(int b, int& R, int& C) { const int st = b / 1024, sb = b % 1024, swz = sb ^ (((sb >> 9) & 1) << 5); R = (st >> 1) * 16 + swz / 64; C = (st & 1) * 32 + (swz % 64) / 2; }
__host__ __device__ __forceinline__ int perm32(int rho) { const int n = rho >> 4, i = rho & 15; return 8 * (i >> 2) + 4 * n + (i & 3); }

struct Unit { int pm, pn, kt0, nt, aux; };
struct Gemm { const bf16_t* A; const bf16_t* Bt; int M, N, K; };

struct StaticOrder {
    int nM, nN, nwg, G, c, ntk;
    __host__ __device__ void init(int M, int N, int K, int G_, int c_) { nM = M / BM; nN = N / BM; nwg = nM * nN; G = G_; c = c_; ntk = K / BK; }
    __host__ __device__ __forceinline__ bool next(int i, Unit& u) const {
        const long L = (long)i * G + c; if (L >= nwg) return false;
        int wgid = (int)L; { const int q = nwg / NXCD, r = nwg % NXCD, xcd = wgid % NXCD, off = wgid / NXCD; wgid = (xcd < r ? xcd * (q + 1) : r * (q + 1) + (xcd - r) * q) + off; }
        const int nig = WGM * nN, gid = wgid / nig, fm = gid * WGM, gsz = (nM - fm) < WGM ? (nM - fm) : WGM;
        u.pm = fm + ((wgid % nig) % gsz); u.pn = (wgid % nig) / gsz; u.kt0 = 0; u.nt = ntk; u.aux = -1; return true;
    }
    __device__ __forceinline__ void a_ready(const Unit&) const {}
    __device__ __forceinline__ void done(const Unit&) const {}
};

__device__ __forceinline__ unsigned cvt_pk_bf16(float lo, float hi) { unsigned r; asm volatile("v_cvt_pk_bf16_f32 %0, %1, %2" : "=v"(r) : "v"(lo), "v"(hi)); return r; }
typedef float f32x2 __attribute__((ext_vector_type(2)));
struct SplitOrder {
    StaticOrder lat; int G, c, e, extra;
    __host__ __device__ void init(int K, int G_, int c_) { lat.init(8192, 2048, K, G_, c_); G = G_; c = c_; const int ntk = K / BK; e = (ntk / 8) & ~1; extra = (ntk - 8 * e) / 2; }
    __host__ __device__ __forceinline__ bool next(int i, Unit& u) const {
        const int item = c + i * G; if (item >= 512) return false;
        const bool ctx = item < 256;
        Unit l; StaticOrder t = lat; t.c = ctx ? 0 : item - 256; t.G = 0; t.next(0, l);
        const int cu = item >> 3, sl = item & 7;
        Unit r;
        r.pm = ctx ? 32 + (cu >> 3) : l.pm; r.pn = ctx ? (cu & 7) : l.pn; r.nt = ctx ? e + (sl < extra ? 2 : 0) : l.nt; r.kt0 = ctx ? e * sl + 2 * (sl < extra ? sl : extra) : 0; r.aux = ctx ? item : -1;
        u = r; return true;
    }
    __device__ __forceinline__ void a_ready(const Unit&) const {}
    __device__ __forceinline__ void done(const Unit&) const {}
};

template <class F> struct EpiRow8 {
    static constexpr bool PERM = true, AFTER_DRAIN = false; F f;
    __device__ __forceinline__ void operator()(const f32x4 (&acc)[2][2][4][2], const Unit& u, int wr, int wc, int fr, int fq) const {
        const int row0 = u.pm * BM + wr * 64 + fr, col0 = u.pn * BM + wc * 32 + 8 * fq;
#pragma unroll
        for (int ai = 0; ai < 2; ++ai)
#pragma unroll
            for (int m = 0; m < 4; ++m)
#pragma unroll
                for (int bj = 0; bj < 2; ++bj) f.apply(u, row0 + ai * HALF + m * 16, col0 + bj * HALF, acc[ai][bj][m][0], acc[ai][bj][m][1]);
    }
};
__device__ __forceinline__ u32x4 pack8(const f32x4 a, const f32x4 b) { u32x4 w; w.x = cvt_pk_bf16(a[0], a[1]); w.y = cvt_pk_bf16(a[2], a[3]); w.z = cvt_pk_bf16(b[0], b[1]); w.w = cvt_pk_bf16(b[2], b[3]); return w; }
struct FPlain {
    bf16_t* O; int ldc;
    __device__ __forceinline__ void apply(const Unit&, int row, int col, f32x4 v0, f32x4 v1) const { *(u32x4*)(O + (size_t)row * ldc + col) = pack8(v0, v1); }
};
struct FRope {
    bf16_t *Q, *K, *V, *G; const float* cosr; const float* sinr; int ML;
    __device__ __forceinline__ void apply(const Unit&, int row, int col, f32x4 v0, f32x4 v1) const {
        if (col < 4096) {
            const bool isk = col >= 2048; const int c = col & 2047;
            if (isk) { v0 = v0 * 0.0625f; v1 = v1 * 0.0625f; }
            if (row < ML) {
                const int t = row & 2047, pi = (c & 255) >> 1;
                const f32x4 cs = *(const f32x4*)(cosr + t * 128 + pi), sn = *(const f32x4*)(sinr + t * 128 + pi);
                f32x4 a, b;
                a[0] = v0[0] * cs[0] - v0[1] * sn[0]; a[1] = v0[0] * sn[0] + v0[1] * cs[0];
                a[2] = v0[2] * cs[1] - v0[3] * sn[1]; a[3] = v0[2] * sn[1] + v0[3] * cs[1];
                b[0] = v1[0] * cs[2] - v1[1] * sn[2]; b[1] = v1[0] * sn[2] + v1[1] * cs[2];
                b[2] = v1[2] * cs[3] - v1[3] * sn[3]; b[3] = v1[2] * sn[3] + v1[3] * cs[3];
                v0 = a; v1 = b;
            }
            *(u32x4*)((isk ? K : Q) + (size_t)row * 2048 + c) = pack8(v0, v1);
        } else if (col < 8192) { *(u32x4*)(V + (size_t)row * 4096 + (col - 4096)) = pack8(v0, v1); }
        else { *(u32x4*)(G + (size_t)row * 4096 + (col - 8192)) = pack8(v0, v1); }
    }
};
struct FRes {
    const float* baseX; const float* baseC; float* XS; const float* gate; int ML; float* slab;
    __device__ __forceinline__ void apply(const Unit& u, int row, int col, f32x4 v0, f32x4 v1) const {
        const int mr = row < ML ? (row >> 11) : 4;
        const float* gp = gate + mr * 12288 + col;
        const f32x4 g0 = *(const f32x4*)gp, g1 = *(const f32x4*)(gp + 4);
        if (u.aux >= 0) { float* o = slab + ((size_t)u.aux * 256 + (row & 255)) * 256 + (col & 255); *(f32x4*)o = g0 * v0; *(f32x4*)(o + 4) = g1 * v1; return; }
        const float* b = (row < ML ? baseX + (size_t)row * 2048 : baseC + (size_t)(row - ML) * 2048) + col;
        const f32x4 b0 = *(const f32x4*)b, b1 = *(const f32x4*)(b + 4);
        float* o = XS + (size_t)row * 2048 + col;
        *(f32x4*)o = b0 + g0 * v0; *(f32x4*)(o + 4) = b1 + g1 * v1;
    }
};
template <class Epi, class Sched, bool ALIGN_EPI = false, bool SP2 = false>
__device__ __forceinline__ void gemm_phase(PG8_LAS unsigned char* lds, const Gemm g, const Sched& S, const Epi& E, const int tid) {
    const int wid = __builtin_amdgcn_readfirstlane(tid >> 6), lane = tid & 63, wr = wid >> 2, wc = wid & 3, fr = lane & 15, fq = lane >> 4;
    const int K = g.K;
    unsigned voffA[2], voffB[2];
#pragma unroll
    for (int i = 0; i < 2; ++i) { int R, C; stage_rc(tid * 16 + i * 8192, R, C); const int Rb = Epi::PERM ? ((R & ~31) + perm32(R & 31)) : R;
        voffA[i] = (unsigned)(R * K + C) * 2u; voffB[i] = (unsigned)(Rb * K + C) * 2u; }
    const size_t kstep = (size_t)(BK * 2);
    const size_t hstep = (size_t)HALF * K * 2;
    const size_t tstep = 2 * hstep;
    const unsigned ldsw = (unsigned)wid * 1024u;
    const int aoff = lds_byte(wr * 64 + fr, fq * 8), boff = lds_byte(wc * 32 + fr, fq * 8);
#define PG8_SA(b, h) (((b) * 2 + (h)) * HTB)
#define PG8_SB(b, h) ((4 + (b) * 2 + (h)) * HTB)
#define PG8_STAGE(bufoff, gbase, voff) do { _Pragma("unroll") for (int _i = 0; _i < 2; ++_i) \
        __builtin_amdgcn_global_load_lds((const unsigned*)((const char*)(gbase) + (voff)[_i]), (PG8_LAS unsigned*)(lds + (bufoff) + ldsw + _i * 8192), 16, 0, 0); } while (0)
#define PG8_LDA(dst, b, h) do { _Pragma("unroll") for (int m = 0; m < 4; ++m) _Pragma("unroll") for (int k = 0; k < 2; ++k) dst[m][k] = *(const PG8_LAS bf16x8*)(lds + PG8_SA(b, h) + aoff + m * 2048 + k * 1024); } while (0)
#define PG8_LDB(dst, b, h) do { _Pragma("unroll") for (int n = 0; n < 2; ++n) _Pragma("unroll") for (int k = 0; k < 2; ++k) dst[n][k] = *(const PG8_LAS bf16x8*)(lds + PG8_SB(b, h) + boff + n * 2048 + k * 1024); } while (0)
#define PG8_MMA(ai, bj, At, Bt) do { __builtin_amdgcn_s_setprio(1); _Pragma("unroll") for (int m = 0; m < 4; ++m) _Pragma("unroll") for (int n = 0; n < 2; ++n) _Pragma("unroll") for (int k = 0; k < 2; ++k) \
        acc[ai][bj][m][n] = __builtin_amdgcn_mfma_f32_16x16x32_bf16(Bt[n][k], At[m][k], acc[ai][bj][m][n], 0, 0, 0); __builtin_amdgcn_s_setprio(0); } while (0)
#define PG8_WAIT_V(n) asm volatile("s_waitcnt vmcnt(" #n ")" ::: "memory")
#define PG8_WAIT_L(n) asm volatile("s_waitcnt lgkmcnt(" #n ")" ::: "memory")
#define PG8_BAR __builtin_amdgcn_s_barrier()
#define PG8_SCHED __builtin_amdgcn_sched_barrier(0)
    Unit cur, nxt; int ui = 0;
    if (!S.next(0, cur)) return;
    f32x4 acc[2][2][4][2];
#pragma unroll
    for (int a = 0; a < 2; ++a)
#pragma unroll
        for (int b = 0; b < 2; ++b)
#pragma unroll
            for (int m = 0; m < 4; ++m)
#pragma unroll
                for (int n = 0; n < 2; ++n) acc[a][b][m][n] = (f32x4){0.f, 0.f, 0.f, 0.f};
    bf16x8 At[4][2], B0[2][2], B1[2][2];
    const char* cA = (const char*)g.A + (size_t)cur.pm * tstep + (size_t)cur.kt0 * kstep; const char* cB = (const char*)g.Bt + (size_t)cur.pn * tstep + (size_t)cur.kt0 * kstep;
    S.a_ready(cur);
    if constexpr (SP2) {
        PG8_STAGE(PG8_SB(0, 0), cB, voffB); PG8_STAGE(PG8_SB(0, 1), cB + hstep, voffB); PG8_STAGE(PG8_SA(0, 0), cA, voffA); PG8_STAGE(PG8_SA(0, 1), cA + hstep, voffA);
        if (wr == 1) PG8_BAR;
        PG8_WAIT_V(2); PG8_BAR;
        PG8_STAGE(PG8_SB(1, 0), cB + kstep, voffB); PG8_STAGE(PG8_SA(1, 0), cA + kstep, voffA); PG8_STAGE(PG8_SB(1, 1), cB + hstep + kstep, voffB);
        PG8_WAIT_V(6); PG8_BAR;
    } else {
        PG8_STAGE(PG8_SB(0, 0), cB, voffB); PG8_STAGE(PG8_SA(0, 0), cA, voffA); PG8_STAGE(PG8_SB(0, 1), cB + hstep, voffB); PG8_STAGE(PG8_SA(0, 1), cA + hstep, voffA);
        if (wr == 1) PG8_BAR;
        PG8_WAIT_V(4); PG8_BAR;
        PG8_STAGE(PG8_SB(1, 0), cB + kstep, voffB); PG8_STAGE(PG8_SA(1, 0), cA + kstep, voffA); PG8_STAGE(PG8_SB(1, 1), cB + hstep + kstep, voffB);
        PG8_WAIT_V(6); PG8_BAR;
    }
    for (;;) {
        const bool has_next = S.next(ui + 1, nxt);
        const char* nA = has_next ? (const char*)g.A + (size_t)nxt.pm * tstep + (size_t)nxt.kt0 * kstep : cA; const char* nB = has_next ? (const char*)g.Bt + (size_t)nxt.pn * tstep + (size_t)nxt.kt0 * kstep : cB;
        const int nt = cur.nt;
        for (int t = 0; t < nt; t += 2) {
            const bool last = (t == nt - 2);
            const char* a1 = cA + (size_t)(t + 1) * kstep;
            const char* a2 = last ? nA : cA + (size_t)(t + 2) * kstep; const char* b2 = last ? nB : cB + (size_t)(t + 2) * kstep;
            const char* a3 = a2 + kstep; const char* b3 = b2 + kstep;
            if (last && has_next) S.a_ready(nxt);
            if constexpr (SP2) {
            PG8_LDB(B0, 0, 0); PG8_LDB(B1, 0, 1); PG8_SCHED; PG8_LDA(At, 0, 0); PG8_STAGE(PG8_SA(1, 1), a1 + hstep, voffA);
            PG8_WAIT_V(8); PG8_WAIT_L(0); PG8_BAR; PG8_MMA(0, 0, At, B0); PG8_MMA(0, 1, At, B1); PG8_BAR; PG8_SCHED;
            PG8_LDA(At, 0, 1); PG8_STAGE(PG8_SB(0, 0), b2, voffB); PG8_STAGE(PG8_SB(0, 1), b2 + hstep, voffB); PG8_STAGE(PG8_SA(0, 0), a2, voffA);
            PG8_WAIT_V(8); PG8_WAIT_L(0); PG8_BAR; PG8_MMA(1, 0, At, B0); PG8_MMA(1, 1, At, B1); PG8_BAR; PG8_SCHED;
            PG8_LDB(B0, 1, 0); PG8_LDB(B1, 1, 1); PG8_SCHED; PG8_LDA(At, 1, 0); PG8_STAGE(PG8_SA(0, 1), a2 + hstep, voffA);
            PG8_WAIT_V(8); PG8_WAIT_L(0); PG8_BAR; PG8_MMA(0, 0, At, B0); PG8_MMA(0, 1, At, B1); PG8_BAR; PG8_SCHED;
            PG8_LDA(At, 1, 1); PG8_STAGE(PG8_SB(1, 0), b3, voffB); PG8_STAGE(PG8_SB(1, 1), b3 + hstep, voffB); PG8_STAGE(PG8_SA(1, 0), a3, voffA);
            PG8_WAIT_V(8); PG8_WAIT_L(0); PG8_BAR; PG8_MMA(1, 0, At, B0); PG8_MMA(1, 1, At, B1); PG8_BAR; PG8_SCHED;
            } else {
            PG8_LDB(B0, 0, 0); PG8_SCHED; PG8_LDA(At, 0, 0); PG8_STAGE(PG8_SA(1, 1), a1 + hstep, voffA);
            PG8_WAIT_L(8); PG8_BAR; PG8_WAIT_L(0); PG8_MMA(0, 0, At, B0); PG8_BAR; PG8_SCHED;
            PG8_LDB(B1, 0, 1); PG8_STAGE(PG8_SB(0, 0), b2, voffB);
            PG8_BAR; PG8_WAIT_L(0); PG8_MMA(0, 1, At, B1); PG8_BAR;
            PG8_LDA(At, 0, 1); PG8_STAGE(PG8_SA(0, 0), a2, voffA);
            PG8_BAR; PG8_WAIT_L(0); PG8_MMA(1, 0, At, B0); PG8_BAR; PG8_SCHED;
            PG8_STAGE(PG8_SB(0, 1), b2 + hstep, voffB);
            PG8_WAIT_V(6); PG8_BAR; PG8_MMA(1, 1, At, B1); PG8_BAR;
            PG8_LDB(B0, 1, 0); PG8_SCHED; PG8_LDA(At, 1, 0); PG8_STAGE(PG8_SA(0, 1), a2 + hstep, voffA);
            PG8_WAIT_L(8); PG8_BAR; PG8_WAIT_L(0); PG8_MMA(0, 0, At, B0); PG8_BAR; PG8_SCHED;
            PG8_LDB(B1, 1, 1); PG8_STAGE(PG8_SB(1, 0), b3, voffB);
            PG8_BAR; PG8_WAIT_L(0); PG8_MMA(0, 1, At, B1); PG8_BAR;
            PG8_LDA(At, 1, 1); PG8_STAGE(PG8_SA(1, 0), a3, voffA);
            PG8_BAR; PG8_WAIT_L(0); PG8_MMA(1, 0, At, B0); PG8_BAR; PG8_SCHED;
            PG8_STAGE(PG8_SB(1, 1), b3 + hstep, voffB);
            PG8_WAIT_V(6); PG8_BAR; PG8_MMA(1, 1, At, B1); PG8_BAR;
            }
        }
        if constexpr (ALIGN_EPI) { if (wr == 0) PG8_BAR; }
        if constexpr (!Epi::AFTER_DRAIN) { E(acc, cur, wr, wc, fr, fq); S.done(cur); }
        if (!has_next) break;
#pragma unroll
        for (int a = 0; a < 2; ++a)
#pragma unroll
            for (int b = 0; b < 2; ++b)
#pragma unroll
                for (int m = 0; m < 4; ++m)
#pragma unroll
                    for (int n = 0; n < 2; ++n) acc[a][b][m][n] = (f32x4){0.f, 0.f, 0.f, 0.f};
        cur = nxt; cA = nA; cB = nB; ++ui;
        if constexpr (ALIGN_EPI) { if (wr == 1) PG8_BAR; }
    }
    PG8_WAIT_V(0);
    if constexpr (!ALIGN_EPI) { if (wr == 0) PG8_BAR; }
    PG8_BAR;
    if constexpr (Epi::AFTER_DRAIN) { E.fused(acc, cur, wr, wc, fr, fq, lds, wid, lane); S.done(cur); }
#undef PG8_SA
#undef PG8_SB
#undef PG8_STAGE
#undef PG8_LDA
#undef PG8_LDB
#undef PG8_MMA
#undef PG8_WAIT_V
#undef PG8_WAIT_L
#undef PG8_BAR
#undef PG8_SCHED
}
}

namespace att {
using bf16 = __hip_bfloat16;
constexpr int D = 128, NW = 8, QBLK = 32, KVBLK = 64;
constexpr float SCALE = 0.088388347648318440f;
constexpr float THR = 8.f;
constexpr int LDQ = 2048, LDK = 512, LDO = 2048;
constexpr size_t SHM_V = KVBLK * D * 2, SHM_K = KVBLK * D * 2, SHM_ATTN = 2 * SHM_V + 2 * SHM_K + NW * 64 * 4;
using bf16x8 = __attribute__((ext_vector_type(8))) short;
using s16x4  = __attribute__((ext_vector_type(4))) short;
using f32x16 = __attribute__((ext_vector_type(16))) float;
using u32x4  = __attribute__((ext_vector_type(4))) unsigned;
#define KSWZ(row, colB) ((row) * 256 + ((colB) ^ (((row) & 7) << 4)))
#define SBAR() __builtin_amdgcn_sched_barrier(0)
__device__ __forceinline__ int crow(int r, int hi) { return (r & 3) + 8 * (r >> 2) + 4 * hi; }
__device__ __forceinline__ unsigned cvtpk(float lo, float hi) { unsigned r; asm volatile("v_cvt_pk_bf16_f32 %0, %1, %2" : "=v"(r) : "v"(lo), "v"(hi)); return r; }
__device__ __forceinline__ void partialSM(f32x16& p0, f32x16& p1, float& m_reg, float& mn, float& alpha) {
  constexpr float C = SCALE * 1.4426950408889634f;
  float pmax = p0[0]; for (int r = 1; r < 16; ++r) pmax = fmaxf(pmax, p0[r]); for (int r = 0; r < 16; ++r) pmax = fmaxf(pmax, p1[r]);
  { auto rr = __builtin_amdgcn_permlane32_swap(__float_as_uint(pmax), __float_as_uint(pmax), false, false);
    pmax = fmaxf(__uint_as_float(rr[0]), __uint_as_float(rr[1])); }
  if (__builtin_expect(__all(pmax - m_reg <= THR / SCALE), 1)) { mn = m_reg; alpha = 1.f; }
  else { mn = fmaxf(m_reg, pmax); alpha = __builtin_amdgcn_exp2f((m_reg - mn) * C); m_reg = mn; }
  float mnC = -mn * C;
  for (int r = 0; r < 16; ++r) p0[r] = fmaf(p0[r], C, mnC); for (int r = 0; r < 16; ++r) p1[r] = fmaf(p1[r], C, mnC);
  for (int r = 0; r < 16; ++r) p0[r] = __builtin_amdgcn_exp2f(p0[r]);
}
__device__ __forceinline__ void finishSM(f32x16& p0, f32x16& p1, float alpha, float& l_reg, bf16x8& pa0, bf16x8& pa1, bf16x8& pa2, bf16x8& pa3) {
  for (int r = 0; r < 16; ++r) p1[r] = __builtin_amdgcn_exp2f(p1[r]);
  float ps = 0; for (int r = 0; r < 16; ++r) ps += p0[r]; for (int r = 0; r < 16; ++r) ps += p1[r];
  { auto rr = __builtin_amdgcn_permlane32_swap(__float_as_uint(ps), __float_as_uint(ps), false, false);
    ps = __uint_as_float(rr[0]) + __uint_as_float(rr[1]); }
  l_reg = l_reg * alpha + ps;
#define PK4(P, BASE, OUT) do { unsigned a0 = cvtpk(P[BASE + 0], P[BASE + 1]), a1 = cvtpk(P[BASE + 2], P[BASE + 3]);   \
    unsigned b0 = cvtpk(P[BASE + 4], P[BASE + 5]), b1 = cvtpk(P[BASE + 6], P[BASE + 7]);                              \
    auto r0 = __builtin_amdgcn_permlane32_swap(a0, b0, false, false); auto r1 = __builtin_amdgcn_permlane32_swap(a1, b1, false, false); \
    u32x4 w = {r0[0], r1[0], r0[1], r1[1]}; OUT = *reinterpret_cast<bf16x8*>(&w); } while (0)
  PK4(p0, 0, pa0); PK4(p0, 8, pa1); PK4(p1, 0, pa2); PK4(p1, 8, pa3);
#undef PK4
}
__device__ __forceinline__ void qkt(f32x16& p0, f32x16& p1, const bf16* Ks, const bf16x8* qr, int r32, int hi) {
  p0 = f32x16{}; p1 = f32x16{};
  for (int d0 = 0; d0 < 8; ++d0) { int cb = (d0 * 16 + hi * 8) * 2;
    bf16x8 b0 = *reinterpret_cast<const bf16x8*>((const char*)Ks + KSWZ(r32, cb));
    bf16x8 b1 = *reinterpret_cast<const bf16x8*>((const char*)Ks + KSWZ(32 + r32, cb));
    p0 = __builtin_amdgcn_mfma_f32_32x32x16_bf16(b0, qr[d0], p0, 0, 0, 0);
    p1 = __builtin_amdgcn_mfma_f32_32x32x16_bf16(b1, qr[d0], p1, 0, 0, 0); }
}
__device__ __forceinline__ int v_st(int k, int c) { const int kk = (k & ~0xC) | ((k & 4) << 1) | ((k & 8) >> 1); return ((kk >> 3) * 4 + (c >> 5)) * 512 + ((kk & 7) * 32 + (c & 31)) * 2; }
__device__ __forceinline__ int v_rd_base(int lane) { return ((lane & 3) << 3) | (((lane >> 2) & 3) << 6) | (((lane >> 4) & 1) << 5) | (((lane >> 5) & 1) << 8); }
constexpr int v_rd_off(int d0, int ks, int half) { return d0 * 512 + ks * 4096 + half * 2048; }
template <int OFF> __device__ __forceinline__ s16x4 tr_read(int vb) {
  s16x4 r; asm volatile("ds_read_b64_tr_b16 %0, %1 offset:%2" : "=&v"(r) : "v"(vb), "i"(OFF) : "memory"); return r;
}
template <int D0> __device__ __forceinline__ void pv_one(f32x16& od, int vb, bf16x8 pa0, bf16x8 pa1, bf16x8 pa2, bf16x8 pa3) {
  const s16x4 l0 = tr_read<v_rd_off(D0, 0, 0)>(vb), h0 = tr_read<v_rd_off(D0, 0, 1)>(vb), l1 = tr_read<v_rd_off(D0, 1, 0)>(vb), h1 = tr_read<v_rd_off(D0, 1, 1)>(vb);
  const s16x4 l2 = tr_read<v_rd_off(D0, 2, 0)>(vb), h2 = tr_read<v_rd_off(D0, 2, 1)>(vb), l3 = tr_read<v_rd_off(D0, 3, 0)>(vb), h3 = tr_read<v_rd_off(D0, 3, 1)>(vb);
  asm volatile("s_waitcnt lgkmcnt(0)" ::: "memory"); SBAR();
#define PK(L, H) (bf16x8){L[0], L[1], L[2], L[3], H[0], H[1], H[2], H[3]}
  od = __builtin_amdgcn_mfma_f32_32x32x16_bf16(pa0, PK(l0, h0), od, 0, 0, 0);
  od = __builtin_amdgcn_mfma_f32_32x32x16_bf16(pa1, PK(l1, h1), od, 0, 0, 0);
  od = __builtin_amdgcn_mfma_f32_32x32x16_bf16(pa2, PK(l2, h2), od, 0, 0, 0);
  od = __builtin_amdgcn_mfma_f32_32x32x16_bf16(pa3, PK(l3, h3), od, 0, 0, 0);
#undef PK
}
__device__ __forceinline__ void pv_d0(f32x16* o, int vb, bf16x8 pa0, bf16x8 pa1, bf16x8 pa2, bf16x8 pa3) {
  pv_one<0>(o[0], vb, pa0, pa1, pa2, pa3); pv_one<1>(o[1], vb, pa0, pa1, pa2, pa3); pv_one<2>(o[2], vb, pa0, pa1, pa2, pa3); pv_one<3>(o[3], vb, pa0, pa1, pa2, pa3);
}
__device__ __forceinline__ void attn_dense_body(const bf16* __restrict__ Qb, const bf16* __restrict__ Kh, const bf16* __restrict__ Vh,
                                                bf16* __restrict__ Ob, int seq, char* lds, const int tid) {
  const int wid = tid >> 6, lane = tid & 63, r32 = lane & 31, hi = lane >> 5;
  bf16* V_lds = (bf16*)lds; bf16* K_lds = (bf16*)(lds + 2 * SHM_V);
  float* ws = (float*)(lds + 2 * SHM_V + 2 * SHM_K) + wid * 64; float* li_l = ws; float* al_l = ws + 32;
  float m_reg = -1e30f, l_reg = 0; f32x16 o[4] = {}; bf16x8 qr[8];
  const bf16* Qw = Qb + (long)(wid * QBLK + r32) * LDQ + hi * 8;
#pragma unroll
  for (int d0 = 0; d0 < 8; ++d0) qr[d0] = *reinterpret_cast<const bf16x8*>(Qw + d0 * 16);
  const int sr = tid >> 4, sc = (tid & 15) * 8, vst0 = v_st(sr, sc), vst1 = v_st(32 + sr, sc);
  const int vb0 = (int)(uintptr_t)V_lds + v_rd_base(lane);
  struct { bf16x8 vs0, vs1, ks0, ks1; } sr_[2];
#define SLOAD(i, k0) do { sr_[i].vs0 = *reinterpret_cast<const bf16x8*>(&Vh[(long)((k0) + sr) * LDK + sc]); sr_[i].vs1 = *reinterpret_cast<const bf16x8*>(&Vh[(long)((k0) + 32 + sr) * LDK + sc]); \
    sr_[i].ks0 = *reinterpret_cast<const bf16x8*>(&Kh[(long)((k0) + sr) * LDK + sc]); sr_[i].ks1 = *reinterpret_cast<const bf16x8*>(&Kh[(long)((k0) + 32 + sr) * LDK + sc]); } while (0)
#define SWRITE(b, i) do { *(bf16x8*)((char*)V_lds + (b) * SHM_V + vst0) = sr_[i].vs0;          \
    *(bf16x8*)((char*)V_lds + (b) * SHM_V + vst1) = sr_[i].vs1; int kc = sc * 2;               \
    *(bf16x8*)((char*)K_lds + (b) * SHM_K + KSWZ(sr, kc)) = sr_[i].ks0;                       \
    *(bf16x8*)((char*)K_lds + (b) * SHM_K + KSWZ(32 + sr, kc)) = sr_[i].ks1; } while (0)
#define SWAIT() do { asm volatile("s_waitcnt vmcnt(4)" ::: "memory"); } while (0)
#define RESC(a) do { if (__any((a) < 1.f)) { if (hi == 0) al_l[r32] = (a); asm volatile("s_waitcnt lgkmcnt(0)" ::: "memory"); \
    for (int d = 0; d < 4; ++d) for (int r = 0; r < 16; ++r) o[d][r] *= al_l[crow(r, hi)]; } } while (0)
  f32x16 pA0, pA1, pB0, pB1; float mnA, mnB, alA, alB; bf16x8 pa0, pa1, pa2, pa3; const int NT = seq / KVBLK;
  constexpr int SE = 0, SO = 1;
  SLOAD(SE, 0); asm volatile("s_waitcnt vmcnt(0)" ::: "memory"); SWRITE(0, SE); __syncthreads();
  qkt(pA0, pA1, K_lds, qr, r32, hi); partialSM(pA0, pA1, m_reg, mnA, alA);
  SLOAD(SO, KVBLK); { if (2 < NT) SLOAD(SE, 2 * KVBLK); }
  SWAIT(); SWRITE(1, SO); __syncthreads();
  for (int j = 1; j + 1 < NT; j += 2) {
    SBAR(); qkt(pB0, pB1, (bf16*)((char*)K_lds + SHM_K), qr, r32, hi);
    finishSM(pA0, pA1, alA, l_reg, pa0, pa1, pa2, pa3); SBAR();
    SLOAD(SO, (j + 2) * KVBLK); SBAR();
    pv_d0(o, vb0, pa0, pa1, pa2, pa3); partialSM(pB0, pB1, m_reg, mnB, alB);
    __syncthreads(); SWAIT(); SWRITE(0, SE);
    RESC(alB); __syncthreads();
    SBAR(); qkt(pA0, pA1, K_lds, qr, r32, hi);
    finishSM(pB0, pB1, alB, l_reg, pa0, pa1, pa2, pa3); SBAR();
    if (j + 3 < NT) SLOAD(SE, (j + 3) * KVBLK); SBAR();
    pv_d0(o, vb0 + (int)SHM_V, pa0, pa1, pa2, pa3); partialSM(pA0, pA1, m_reg, mnA, alA);
    __syncthreads(); SWAIT(); SWRITE(1, SO);
    RESC(alA); __syncthreads();
  }
  SBAR(); qkt(pB0, pB1, (bf16*)((char*)K_lds + SHM_K), qr, r32, hi);
  finishSM(pA0, pA1, alA, l_reg, pa0, pa1, pa2, pa3); SBAR();
  pv_d0(o, vb0, pa0, pa1, pa2, pa3); partialSM(pB0, pB1, m_reg, mnB, alB);
  __syncthreads(); RESC(alB);
  finishSM(pB0, pB1, alB, l_reg, pa0, pa1, pa2, pa3); SBAR();
  pv_d0(o, vb0 + (int)SHM_V, pa0, pa1, pa2, pa3);
  if (hi == 0) li_l[r32] = l_reg; asm volatile("s_waitcnt lgkmcnt(0)" ::: "memory");
  float rli[16];
#pragma unroll
  for (int r = 0; r < 16; ++r) rli[r] = __builtin_amdgcn_rcpf(li_l[crow(r, hi)]);
  bf16* Ow = Ob + (long)(wid * QBLK) * LDO;
#pragma unroll
  for (int r = 0; r < 16; ++r) { int orow = crow(r, hi);
    for (int d0 = 0; d0 < 4; ++d0) Ow[(long)orow * LDO + d0 * 32 + r32] = __float2bfloat16(o[d0][r] * rli[r]); }
#undef SLOAD
#undef SWRITE
#undef SWAIT
#undef RESC
}
}

typedef unsigned short bf16_t;
typedef short bf16x8 __attribute__((ext_vector_type(8)));
typedef short s16x4 __attribute__((ext_vector_type(4)));
typedef float f32x4 __attribute__((ext_vector_type(4)));
typedef unsigned u32x4 __attribute__((ext_vector_type(4)));
typedef unsigned u32x2 __attribute__((ext_vector_type(2)));
#define LAS __attribute__((address_space(3)))

constexpr int DM = 2048, NBATCH = 4, SEQ = 2048, CTXL = 256, ML = NBATCH * SEQ, MC = NBATCH * CTXL, MT = ML + MC;
constexpr int FF = 5632, FF2 = 2 * FF, NRIN = 6 * DM, NAIN = 3072, SKV = CTXL + SEQ;
constexpr int NWAVES = 8, NTHR = 512;
constexpr int LDS_BYTES = 144 * 1024, BAR_LDS_OFF = 140 * 1024;
constexpr float EPS = 1e-6f;

constexpr size_t al256(size_t x) { return (x + 255) / 256 * 256; }
constexpr size_t WS_CTL   = 0;
constexpr size_t WS_MOD   = 16384;
constexpr size_t WS_ROPER = WS_MOD + al256((size_t)2 * 5 * 12288 * 4);
constexpr size_t WS_ROPEA = WS_ROPER + (size_t)2 * 2048 * 128 * 4;
constexpr size_t WS_WRIN  = WS_ROPEA + (size_t)2 * 2048 * 64 * 4;
constexpr size_t WS_WROUT = WS_WRIN + (size_t)NRIN * DM * 2;
constexpr size_t WS_WAIN  = WS_WROUT + (size_t)DM * 2 * DM * 2;
constexpr size_t WS_WAOUT = WS_WAIN + (size_t)NAIN * DM * 2;
constexpr size_t WS_WUP   = WS_WAOUT + (size_t)DM * DM * 2;
constexpr size_t WS_WDN   = WS_WUP + (size_t)2 * FF2 * DM * 2;
constexpr size_t WS_XS    = WS_WDN + (size_t)2 * DM * FF * 2;
constexpr size_t WS_H     = WS_XS + (size_t)MT * DM * 4;
constexpr size_t WS_R1    = WS_H + (size_t)MT * DM * 2;
constexpr size_t R1_Q = 0, R1_K = (size_t)MT * DM * 2, R1_V = 2 * R1_K, R1_G = R1_V + (size_t)MT * 4096 * 2, R1_BYTES = R1_G + (size_t)MT * 4096 * 2;
constexpr size_t R1_QN = 0, R1_KN = (size_t)ML * DM * 2, R1_VN = R1_KN + (size_t)NBATCH * SKV * 512 * 2, R1_O = R1_VN + (size_t)NBATCH * SKV * 512 * 2;
constexpr size_t WS_R2    = WS_R1 + R1_BYTES;
constexpr size_t R2_BYTES = (size_t)2 * MT * 4096 * 2;
constexpr size_t WS_END   = WS_R2 + R2_BYTES;
static_assert((size_t)MT * FF2 * 2 <= R1_BYTES, "U fits region 1");
static_assert(R1_O + (size_t)ML * DM * 2 <= R1_BYTES, "layer-1 attention tensors fit region 1");

struct Args { const float* in[20]; float* out; unsigned char* ws; int ph_lo, ph_hi; };
enum { I_X = 0, I_C, I_CTX, I_CCTX, I_ADAW, I_ADAB, I_NORMW, I_RWIN, I_RWOUT, I_RLD, I_RGN, I_AWIN, I_AWOUT, I_AQN, I_AKN, I_FUP, I_FCW, I_FCB, I_FDN, I_FNW };
constexpr int NPH = 20;
#ifndef ONLY_PHASE
#define PHSEL(p) (p)
#else
#define PHSEL(p) ((p) == ONLY_PHASE ? ONLY_PHASE : -1)
#endif

__device__ __forceinline__ float wave_sum(float v) {
#pragma unroll
    for (int o = 1; o < 64; o <<= 1) v += __shfl_xor(v, o);
    return v;
}
__device__ __forceinline__ unsigned pk2(float lo, float hi) { unsigned r; asm volatile("v_cvt_pk_bf16_f32 %0, %1, %2" : "=v"(r) : "v"(lo), "v"(hi)); return r; }
__device__ __forceinline__ float bf2f(unsigned short h) { return __uint_as_float((unsigned)h << 16); }
__device__ __forceinline__ float silu_f(float x) { return x / (1.f + __expf(-x)); }
__device__ __forceinline__ void unpack8(const bf16x8 v, float* f) {
#pragma unroll
    for (int i = 0; i < 8; ++i) f[i] = bf2f((unsigned short)v[i]);
}
__device__ __forceinline__ u32x4 pack8f(const float* f) { u32x4 w; w.x = pk2(f[0], f[1]); w.y = pk2(f[2], f[3]); w.z = pk2(f[4], f[5]); w.w = pk2(f[6], f[7]); return w; }

constexpr int TR_SCR = 64 * 65 * 4;
__device__ __forceinline__ void transpose_item(const float* __restrict__ W, int K, int N, bf16_t* __restrict__ WT, LAS float* scr, int item, int lane) {
    const int nblk = N / 64, kb = item / nblk, nb = item % nblk, k0 = 64 * kb, n0 = 64 * nb;
    const int lr = lane >> 4, lc = (lane & 15) * 4;
#pragma unroll 8
    for (int i = 0; i < 16; ++i) { const int kk = 4 * i + lr; const f32x4 v = *(const f32x4*)(W + (size_t)(k0 + kk) * N + n0 + lc);
        LAS float* d = scr + kk * 65 + lc; d[0] = v[0]; d[1] = v[1]; d[2] = v[2]; d[3] = v[3]; }
    asm volatile("s_waitcnt lgkmcnt(0)" ::: "memory");
    const int c = lane & 7;
#pragma unroll
    for (int j = 0; j < 8; ++j) { const int n = (lane >> 3) + 8 * j; const LAS float* sp = scr + (8 * c) * 65 + n;
        u32x4 o; o.x = pk2(sp[0 * 65], sp[1 * 65]); o.y = pk2(sp[2 * 65], sp[3 * 65]); o.z = pk2(sp[4 * 65], sp[5 * 65]); o.w = pk2(sp[6 * 65], sp[7 * 65]);
        *(u32x4*)(WT + (size_t)(n0 + n) * K + k0 + 8 * c) = o; }
    asm volatile("s_waitcnt lgkmcnt(0)" ::: "memory");
}
__device__ __forceinline__ void convert_jobs(int list, const Args& a, unsigned char* ws, LAS unsigned char* lds, int widx, int nw, int wave, int lane) {
    if (widx < 0) return;
    LAS float* scr = (LAS float*)(lds + wave * TR_SCR);
    const int gw = widx * NWAVES + wave, NGW = nw * NWAVES;
    constexpr int I_RIN = (DM / 64) * (NRIN / 64), I_ROUT = (2 * DM / 64) * (DM / 64), I_AIN = (DM / 64) * (NAIN / 64), I_AOUT = (DM / 64) * (DM / 64), I_UP = (DM / 64) * (FF2 / 64), I_DN = (FF / 64) * (DM / 64);
    if (list == 0) {
        for (int it = gw; it < I_RIN + I_UP + I_DN; it += NGW) { int r = it;
            if (r < I_RIN) { transpose_item(a.in[I_RWIN], DM, NRIN, (bf16_t*)(ws + WS_WRIN), scr, r, lane); continue; } r -= I_RIN;
            if (r < I_UP) { transpose_item(a.in[I_FUP], DM, FF2, (bf16_t*)(ws + WS_WUP), scr, r, lane); continue; } r -= I_UP;
            transpose_item(a.in[I_FDN], FF, DM, (bf16_t*)(ws + WS_WDN), scr, r, lane); }
    } else if (list == 1) {
        for (int it = gw; it < I_ROUT; it += NGW) transpose_item(a.in[I_RWOUT], 2 * DM, DM, (bf16_t*)(ws + WS_WROUT), scr, it, lane);
    } else {
        for (int it = gw; it < I_AIN + I_AOUT + I_UP + I_DN; it += NGW) { int r = it;
            if (r < I_AIN) { transpose_item(a.in[I_AWIN], DM, NAIN, (bf16_t*)(ws + WS_WAIN), scr, r, lane); continue; } r -= I_AIN;
            if (r < I_AOUT) { transpose_item(a.in[I_AWOUT], DM, DM, (bf16_t*)(ws + WS_WAOUT), scr, r, lane); continue; } r -= I_AOUT;
            if (r < I_UP) { transpose_item(a.in[I_FUP] + (size_t)DM * FF2, DM, FF2, (bf16_t*)(ws + WS_WUP) + (size_t)FF2 * DM, scr, r, lane); continue; } r -= I_UP;
            transpose_item(a.in[I_FDN] + (size_t)FF * DM, FF, DM, (bf16_t*)(ws + WS_WDN) + (size_t)DM * FF, scr, r, lane); }
    }
}
__device__ __forceinline__ void phase_prologue(const Args& a, unsigned char* ws, LAS unsigned char* lds, int bid, int G, int tid, int wave, int lane) {
    convert_jobs(0, a, ws, lds, bid, G, wave, lane);
    __syncthreads();
    {
        LAS float* act = (LAS float*)lds;
        LAS float* red = (LAS float*)(lds + 40960);
        for (int i = tid; i < 5 * DM; i += NTHR) { const int r = i / DM, k = i % DM; const float v = r < 4 ? a.in[I_C][r * DM + k] : a.in[I_CCTX][k]; act[i] = silu_f(v); }
        __syncthreads();
        const int c4 = tid & 15, ks = tid >> 4;
        for (int it = bid; it < 2 * 192 * 2; it += G) {
            const int kh = it & 1, l = (it >> 1) / 192, c0 = ((it >> 1) % 192) * 64, kbase = kh * 1024 + ks * 32;
            f32x4 acc[5];
#pragma unroll
            for (int r = 0; r < 5; ++r) acc[r] = (f32x4){0.f, 0.f, 0.f, 0.f};
            const float* wp = a.in[I_ADAW] + (size_t)l * DM * 12288 + (size_t)kbase * 12288 + c0 + c4 * 4;
#pragma unroll 8
            for (int kk = 0; kk < 32; ++kk) { const f32x4 w = *(const f32x4*)(wp + (size_t)kk * 12288);
#pragma unroll
                for (int r = 0; r < 5; ++r) acc[r] += act[r * DM + kbase + kk] * w; }
#pragma unroll
            for (int r = 0; r < 5; ++r) *(LAS f32x4*)(red + (ks * 5 + r) * 64 + c4 * 4) = acc[r];
            __syncthreads();
            if (tid < 320) { const int r = tid >> 6, c = tid & 63; float sm = 0.f;
                for (int k2 = 0; k2 < 32; ++k2) sm += red[(k2 * 5 + r) * 64 + c];
                if (kh == 0) sm += a.in[I_ADAB][l * 12288 + c0 + c];
                atomicAdd((float*)(ws + WS_MOD) + (size_t)(l * 5 + r) * 12288 + c0 + c, sm); }
            __syncthreads();
        }
    }
    {
        float* cr = (float*)(ws + WS_ROPER); float* sr = cr + 2048 * 128; float* ca = (float*)(ws + WS_ROPEA); float* sa = ca + 2048 * 64;
        const int gt = bid * NTHR + tid, NT = G * NTHR;
        for (int idx = gt; idx < 2048 * 128; idx += NT) { const int t = idx >> 7, i = idx & 127, f = i & 63; const int pos = (i < 64) ? (t >> 6) : (t & 63);
            const float inv = powf(10000.f, -(float)f / 64.f), ang = (float)pos * inv; float s, c; sincosf(ang, &s, &c); cr[idx] = c; sr[idx] = s; }
        for (int idx = gt; idx < 2048 * 64; idx += NT) { const int t = idx >> 6, i = idx & 63, f = i & 31; const int pos = (i < 32) ? (t >> 6) : (t & 63);
            const float inv = powf(10000.f, -(float)f / 32.f), ang = (float)pos * inv; float s, c; sincosf(ang, &s, &c); ca[idx] = c; sa[idx] = s; }
    }
}

__device__ __forceinline__ void phase_norm(const float* srcX, const float* srcC, const float* nw, const float* mod  , int shoff, bf16_t* H, int nrows,
                                           const float* slab, float* XS, int bid, int G, int wave, int lane) {
    const int gw = bid * NWAVES + wave, NGW = G * NWAVES;
    const int WC = slab ? 9 : 1, nlat = nrows < ML ? nrows : ML, vtot = nlat + (nrows - nlat) * WC;
    const int v_lo = (int)((long)gw * vtot / NGW), v_hi = (int)((long)(gw + 1) * vtot / NGW);
    const int r_lo = v_lo <= nlat ? v_lo : nlat + (v_lo - nlat + WC - 1) / WC, r_hi = v_hi <= nlat ? v_hi : nlat + (v_hi - nlat + WC - 1) / WC;
    f32x4 A[8], B[8]; int cur_mr = -1;
    for (int row = r_lo; row < r_hi; ++row) {
        const float* src = row < ML ? srcX + (size_t)row * DM : srcC + (size_t)(row - ML) * DM;
        const int mr = row < ML ? (row >> 11) : 4;
        f32x4 v[8]; float ss = 0.f;
#pragma unroll
        for (int j = 0; j < 8; ++j) v[j] = *(const f32x4*)(src + (lane + 64 * j) * 4);
        if (slab && row >= ML) {
            const float* sp = slab + ((size_t)((row - ML) >> 8) * 64 * 256 + (row & 255)) * 256;
#pragma unroll
            for (int j = 0; j < 8; ++j) { const int c = (lane + 64 * j) * 4; const float* sq = sp + (size_t)(c >> 8) * 8 * 65536 + (c & 255);
#pragma unroll
                for (int sl = 0; sl < 8; ++sl) v[j] += *(const f32x4*)(sq + (size_t)sl * 65536);
                *(f32x4*)(XS + (size_t)row * DM + c) = v[j]; }
        }
#pragma unroll
        for (int j = 0; j < 8; ++j) ss += (v[j][0] * v[j][0] + v[j][1] * v[j][1]) + (v[j][2] * v[j][2] + v[j][3] * v[j][3]);
        if (mr != cur_mr) { cur_mr = mr; const float* sh = mod + mr * 12288 + shoff; const float* sc = sh + DM;
#pragma unroll
            for (int j = 0; j < 8; ++j) { const int c = (lane + 64 * j) * 4; A[j] = *(const f32x4*)(nw + c) * (1.f + *(const f32x4*)(sc + c)); B[j] = *(const f32x4*)(sh + c); } }
        const float rstd = 1.0f / sqrtf(wave_sum(ss) * (1.f / DM) + EPS);
#pragma unroll
        for (int j = 0; j < 8; ++j) { const int c = (lane + 64 * j) * 4; const f32x4 h = (v[j] * rstd) * A[j] + B[j];
            u32x2 o; o.x = pk2(h[0], h[1]); o.y = pk2(h[2], h[3]); *(u32x2*)(H + (size_t)row * DM + c) = o; }
    }
}
__device__ __forceinline__ void phase_final(const float* XS, const float* nw, float* out, int bid, int G, int wave, int lane) {
    const int gw = bid * NWAVES + wave, NGW = G * NWAVES;
    for (int row = gw; row < ML; row += NGW) {
        const float* src = XS + (size_t)row * DM;
        f32x4 v[8]; float ss = 0.f;
#pragma unroll
        for (int j = 0; j < 8; ++j) { v[j] = *(const f32x4*)(src + (lane + 64 * j) * 4); ss += (v[j][0] * v[j][0] + v[j][1] * v[j][1]) + (v[j][2] * v[j][2] + v[j][3] * v[j][3]); }
        const float rstd = 1.0f / sqrtf(wave_sum(ss) * (1.f / DM) + EPS);
#pragma unroll
        for (int j = 0; j < 8; ++j) { const int c = (lane + 64 * j) * 4; const f32x4 w = *(const f32x4*)(nw + c); *(f32x4*)(out + (size_t)row * DM + c) = (v[j] * rstd) * w; }
    }
}

constexpr int RP = 136;
constexpr int RT_BYTES = 128 * RP * 2;
__device__ __forceinline__ bf16x8 ret_trfrag(const LAS bf16_t* T, int k0, int c0, int lane) {
    const int i = lane & 15, g = lane >> 4, q = i >> 2, p = i & 3;
    const LAS bf16_t* a1 = T + (k0 + 8 * g + q) * RP + c0 + 4 * p;
    const s16x4 lo = __builtin_amdgcn_ds_read_tr16_b64_v4i16((LAS s16x4*)a1);
    const s16x4 hi = __builtin_amdgcn_ds_read_tr16_b64_v4i16((LAS s16x4*)(a1 + 4 * RP));
    return (bf16x8){lo[0], lo[1], lo[2], lo[3], hi[0], hi[1], hi[2], hi[3]};
}
typedef int i32x4 __attribute__((ext_vector_type(4)));
__device__ __forceinline__ void ret_gload(bf16x8 (&r)[4], const bf16_t* src  , int ld, int tid) {
    const auto rs = __builtin_amdgcn_make_buffer_rsrc((void*)src, 0, 0x7fffffff, 0x00020000);
    const unsigned off0 = ((unsigned)(tid >> 4) * (unsigned)ld + (unsigned)(tid & 15) * 8u) * 2u;
#pragma unroll
    for (int i = 0; i < 4; ++i) r[i] = __builtin_bit_cast(bf16x8, __builtin_amdgcn_raw_buffer_load_b128(rs, off0, i * 32 * ld * 2, 0));
}
__device__ __forceinline__ void ret_lwrite(LAS bf16_t* dst, const bf16x8 (&r)[4], int tid) {
#pragma unroll
    for (int i = 0; i < 4; ++i) { const int id = tid + NTHR * i, row = id >> 4, cc = id & 15; *(LAS bf16x8*)(dst + row * RP + cc * 8) = r[i]; }
}
__device__ __forceinline__ int ret_row0(int s, int dir, int b) {
    const bool isctx = s < 2; const int ci = dir == 0 ? (isctx ? s : s - 2) : (isctx ? 1 - s : 17 - s);
    return isctx ? ML + b * CTXL + ci * 128 : b * SEQ + ci * 128;
}
#define RET_SCORES() do { \
    _Pragma("unroll") for (int ks = 0; ks < 4; ++ks) { bf16x8 qf[2], kf[4]; \
        _Pragma("unroll") for (int a_ = 0; a_ < 2; ++a_) qf[a_] = *(const LAS bf16x8*)(QH + (16 * (qt0 + a_) + fr) * RP + ks * 32 + 8 * g); \
        _Pragma("unroll") for (int c_ = 0; c_ < 4; ++c_) kf[c_] = *(const LAS bf16x8*)(KH + (16 * (kt0 + c_) + fr) * RP + ks * 32 + 8 * g); \
        _Pragma("unroll") for (int a_ = 0; a_ < 2; ++a_) _Pragma("unroll") for (int c_ = 0; c_ < 4; ++c_) sc[a_][c_] = __builtin_amdgcn_mfma_f32_16x16x32_bf16(kf[c_], qf[a_], sc[a_][c_], 0, 0, 0); \
        __builtin_amdgcn_sched_barrier(0); } } while (0)
#define RET_INTER_UPDATE(HH) do { \
    _Pragma("unroll") for (int p = 0; p < 4; ++p) { \
        const f32x4 sa = S[8 * (HH) + 2 * p], sb = S[8 * (HH) + 2 * p + 1]; \
        u32x4 bw; bw.x = pk2(sa[0], sa[1]); bw.y = pk2(sa[2], sa[3]); bw.z = pk2(sb[0], sb[1]); bw.w = pk2(sb[2], sb[3]); \
        const bf16x8 sfrag = __builtin_bit_cast(bf16x8, bw); \
        _Pragma("unroll") for (int nt = 0; nt < 8; ++nt) { \
            const LAS bf16_t* qa = QH + (16 * nt + fr) * RP + 32 * p + 4 * g; \
            const s16x4 lo = *(const LAS s16x4*)qa, hi = *(const LAS s16x4*)(qa + 16); \
            const bf16x8 qfrag = (bf16x8){lo[0], lo[1], lo[2], lo[3], hi[0], hi[1], hi[2], hi[3]}; \
            oi[nt] = __builtin_amdgcn_mfma_f32_16x16x32_bf16(sfrag, qfrag, oi[nt], 0, 0, 0); \
            if (nt == 3) __builtin_amdgcn_sched_barrier(0); } \
        __builtin_amdgcn_sched_barrier(0); } \
    { const float cd = __builtin_amdgcn_exp2f(lg2 * 128.f); \
      _Pragma("unroll") for (int j = 0; j < 8; ++j) S[8 * (HH) + j] = S[8 * (HH) + j] * cd; } \
    _Pragma("unroll") for (int ks = 0; ks < 4; ++ks) { \
        bf16x8 vf = ret_trfrag(VV, 32 * ks, ew, lane_o); \
        { float f[8]; unpack8(vf, f); \
          _Pragma("unroll") for (int jj = 0; jj < 8; ++jj) { const int m = 32 * ks + 8 * g + jj; f[jj] *= __builtin_amdgcn_exp2f(lg2 * (float)(dir == 0 ? 127 - m : m)); } \
          vf = __builtin_bit_cast(bf16x8, pack8f(f)); } \
        _Pragma("unroll") for (int j = 0; j < 8; ++j) { const bf16x8 kT = ret_trfrag(KH, 32 * ks, 16 * j, lane_o); \
            S[8 * (HH) + j] = __builtin_amdgcn_mfma_f32_16x16x32_bf16(kT, vf, S[8 * (HH) + j], 0, 0, 0); \
            if (j == 3) __builtin_amdgcn_sched_barrier(0); } \
        __builtin_amdgcn_sched_barrier(0); } } while (0)
__device__ __forceinline__ void phase_retention(const bf16_t* Qb, const bf16_t* Kb, const bf16_t* Vb, bf16_t* OD, const float* logdecay, LAS unsigned char* lds, int bid, int G, int tid, int wave, int lane) {
    LAS bf16_t* QH = (LAS bf16_t*)lds; LAS bf16_t* KH = (LAS bf16_t*)(lds + RT_BYTES); LAS bf16_t* VV = (LAS bf16_t*)(lds + 2 * RT_BYTES); LAS bf16_t* PP = (LAS bf16_t*)(lds + 3 * RT_BYTES);
    const int ew = 16 * wave;
    const int qt0 = 2 * (wave >> 1), kt0 = 4 * (wave & 1);
    for (int u = bid; u < 256; u += G) {
        const int es = u & 3, dir = (u >> 2) & 1, h = (u >> 3) & 7, b = u >> 6, e0 = es * 128;
        const float lg2u = -expf(logdecay[dir * 8 + h]) * 1.4426950408889634f;
        f32x4 S[16];
#pragma unroll
        for (int i = 0; i < 16; ++i) S[i] = (f32x4){0.f, 0.f, 0.f, 0.f};
        bf16x8 RQ[4], RK[4], RV[4];
        { const int r0 = ret_row0(0, dir, b);
          ret_gload(RV, Vb + (size_t)r0 * 4096 + h * 512 + e0, 4096, tid); ret_gload(RQ, Qb + (size_t)r0 * 2048 + h * 256, 2048, tid); ret_gload(RK, Kb + (size_t)r0 * 2048 + h * 256, 2048, tid); }
        for (int s = 0; s < 18; ++s) {
            int tid_o = tid; asm volatile("" : "+v"(tid_o)); const int lane_o = tid_o & 63, fr = lane_o & 15, g = lane_o >> 4;
            float lg2 = lg2u; asm volatile("" : "+v"(lg2));
            const int row0 = ret_row0(s, dir, b);
            const bf16_t* qp = Qb + (size_t)row0 * 2048 + h * 256; const bf16_t* kp = Kb + (size_t)row0 * 2048 + h * 256;
            f32x4 oi[8];
            __syncthreads();
            ret_lwrite(VV, RV, tid_o); ret_lwrite(QH, RQ, tid_o); ret_lwrite(KH, RK, tid_o);
            __syncthreads();
            ret_gload(RQ, qp + 128, 2048, tid_o); ret_gload(RK, kp + 128, 2048, tid_o);
            {
                f32x4 sc[2][4];
#pragma unroll
                for (int i = 0; i < 2; ++i)
#pragma unroll
                    for (int j = 0; j < 4; ++j) sc[i][j] = (f32x4){0.f, 0.f, 0.f, 0.f};
                RET_SCORES();
                __syncthreads();
                ret_lwrite(QH, RQ, tid_o); ret_lwrite(KH, RK, tid_o);
                __syncthreads();
                ret_gload(RQ, qp, 2048, tid_o); ret_gload(RK, kp, 2048, tid_o);
                RET_SCORES();
#pragma unroll
                for (int a = 0; a < 2; ++a)
#pragma unroll
                    for (int c = 0; c < 4; ++c) { const int n = 16 * (qt0 + a) + fr, m0 = 16 * (kt0 + c) + 4 * g; float pv[4];
#pragma unroll
                        for (int r = 0; r < 4; ++r) { const int m = m0 + r; const int dd = dir == 0 ? n - m : m - n; pv[r] = dd >= 0 ? sc[a][c][r] * __builtin_amdgcn_exp2f(lg2 * (float)dd) : 0.f; }
                        u32x2 w; w.x = pk2(pv[0], pv[1]); w.y = pk2(pv[2], pv[3]); *(LAS u32x2*)(PP + n * RP + m0) = w; }
            }
#pragma unroll
            for (int i = 0; i < 8; ++i) oi[i] = (f32x4){0.f, 0.f, 0.f, 0.f};
            RET_INTER_UPDATE(1);
            __syncthreads();
            ret_lwrite(QH, RQ, tid_o); ret_lwrite(KH, RK, tid_o);
            __syncthreads();
            if (s + 1 < 18) { const int r1 = ret_row0(s + 1, dir, b);
                ret_gload(RV, Vb + (size_t)r1 * 4096 + h * 512 + e0, 4096, tid_o); ret_gload(RQ, Qb + (size_t)r1 * 2048 + h * 256, 2048, tid_o); ret_gload(RK, Kb + (size_t)r1 * 2048 + h * 256, 2048, tid_o); }
            RET_INTER_UPDATE(0);
#pragma unroll
            for (int nt = 0; nt < 8; ++nt) { const int n = 16 * nt + fr; const float qd = __builtin_amdgcn_exp2f(lg2 * (float)(dir == 0 ? n + 1 : 128 - n)); oi[nt] = oi[nt] * qd; }
#pragma unroll
            for (int ks = 0; ks < 4; ++ks) { const bf16x8 vf = ret_trfrag(VV, 32 * ks, ew, lane_o);
#pragma unroll
                for (int nt = 0; nt < 8; ++nt) { const bf16x8 pf = *(const LAS bf16x8*)(PP + (16 * nt + fr) * RP + 32 * ks + 8 * g);
                    oi[nt] = __builtin_amdgcn_mfma_f32_16x16x32_bf16(vf, pf, oi[nt], 0, 0, 0);
                    if (nt == 3) __builtin_amdgcn_sched_barrier(0); }
                __builtin_amdgcn_sched_barrier(0); }
            bf16_t* op = OD + (size_t)dir * MT * 4096 + (size_t)row0 * 4096 + h * 512 + e0 + ew;
            const unsigned ooff = ((unsigned)fr * 4096u + 4u * (unsigned)g) * 2u;
            const auto ors = __builtin_amdgcn_make_buffer_rsrc((void*)op, 0, 0x7fffffff, 0x00020000);
#pragma unroll
            for (int nt = 0; nt < 8; ++nt) { u32x2 w; w.x = pk2(oi[nt][0], oi[nt][1]); w.y = pk2(oi[nt][2], oi[nt][3]); __builtin_amdgcn_raw_buffer_store_b64(w, ors, ooff, 16 * nt * 4096 * 2, 0); }
        }
        __syncthreads();
    }
}
#undef RET_SCORES
#undef RET_INTER_UPDATE
__device__ __forceinline__ void phase_combine(const bf16_t* OD, const bf16_t* Gb, const float* gnw, bf16_t* Y, int bid, int G, int wave, int lane) {
    const int gw = bid * NWAVES + wave, NGW = G * NWAVES;
    for (int it = gw; it < MT * 8; it += NGW) {
        const int row = it >> 3, h = it & 7; const size_t off = (size_t)row * 4096 + h * 512 + lane * 8;
        float a[8], b2[8], gg[8];
        unpack8(*(const bf16x8*)(OD + off), a); unpack8(*(const bf16x8*)(OD + (size_t)MT * 4096 + off), b2); unpack8(*(const bf16x8*)(Gb + off), gg);
        float s = 0.f;
#pragma unroll
        for (int i = 0; i < 8; ++i) { a[i] += b2[i]; s += a[i]; }
        const float mu = wave_sum(s) * (1.f / 512.f); float q = 0.f;
#pragma unroll
        for (int i = 0; i < 8; ++i) { a[i] -= mu; q += a[i] * a[i]; }
        const float rstd = 1.0f / sqrtf(wave_sum(q) * (1.f / 512.f) + EPS);
        const f32x4 w0 = *(const f32x4*)(gnw + h * 512 + lane * 8), w1 = *(const f32x4*)(gnw + h * 512 + lane * 8 + 4);
        float o[8];
#pragma unroll
        for (int i = 0; i < 8; ++i) o[i] = a[i] * rstd * (i < 4 ? w0[i] : w1[i - 4]) * silu_f(gg[i]);
        *(u32x4*)(Y + off) = pack8f(o);
    }
}
constexpr int CONV_R = 16;
__device__ __forceinline__ void phase_conv(const bf16_t* __restrict__ U, const float* __restrict__ cw, const float* __restrict__ cb, bf16_t* __restrict__ ACT, int nrows, int bid, int G, int tid) {
    const int gt = bid * NTHR + tid, NT = G * NTHR, total = (nrows / CONV_R) * (FF / 8);
    for (int idx = gt; idx < total; idx += NT) {
        const int ch = idx / (FF / 8), f0 = (idx % (FF / 8)) * 8, row0 = ch * CONV_R;
        int t0, len; if (row0 < ML) { t0 = row0 & (SEQ - 1); len = SEQ; } else { t0 = (row0 - ML) & (CTXL - 1); len = CTXL; }
        float wa[3][8], wb[3][8], ba[8], bb[8];
#pragma unroll
        for (int j = 0; j < 3; ++j) { const f32x4 a0 = *(const f32x4*)(cw + j * FF2 + f0), a1 = *(const f32x4*)(cw + j * FF2 + f0 + 4), b0 = *(const f32x4*)(cw + j * FF2 + FF + f0), b1 = *(const f32x4*)(cw + j * FF2 + FF + f0 + 4);
#pragma unroll
            for (int i = 0; i < 4; ++i) { wa[j][i] = a0[i]; wa[j][4 + i] = a1[i]; wb[j][i] = b0[i]; wb[j][4 + i] = b1[i]; } }
        { const f32x4 a0 = *(const f32x4*)(cb + f0), a1 = *(const f32x4*)(cb + f0 + 4), b0 = *(const f32x4*)(cb + FF + f0), b1 = *(const f32x4*)(cb + FF + f0 + 4);
#pragma unroll
          for (int i = 0; i < 4; ++i) { ba[i] = a0[i]; ba[4 + i] = a1[i]; bb[i] = b0[i]; bb[4 + i] = b1[i]; } }
        const bf16_t* up = U + (size_t)row0 * FF2 + f0;
        const bf16x8 z8 = (bf16x8){0, 0, 0, 0, 0, 0, 0, 0};
        bf16x8 pa = t0 > 0 ? *(const bf16x8*)(up - FF2) : z8, pb = t0 > 0 ? *(const bf16x8*)(up - FF2 + FF) : z8;
        bf16x8 ca = *(const bf16x8*)up, cbv = *(const bf16x8*)(up + FF);
#pragma unroll 4
        for (int r = 0; r < CONV_R; ++r) {
            const bool hn = (r + 1 < CONV_R) || (t0 + CONV_R < len);
            const bf16x8 na = hn ? *(const bf16x8*)(up + (size_t)(r + 1) * FF2) : z8, nb = hn ? *(const bf16x8*)(up + (size_t)(r + 1) * FF2 + FF) : z8;
            float p0[8], p1[8], c0[8], c1[8], n0[8], n1[8], o[8];
            unpack8(pa, p0); unpack8(pb, p1); unpack8(ca, c0); unpack8(cbv, c1); unpack8(na, n0); unpack8(nb, n1);
#pragma unroll
            for (int i = 0; i < 8; ++i) { const float xa = ba[i] + p0[i] * wa[0][i] + c0[i] * wa[1][i] + n0[i] * wa[2][i], xb = bb[i] + p1[i] * wb[0][i] + c1[i] * wb[1][i] + n1[i] * wb[2][i]; o[i] = silu_f(xa) * xb; }
            *(u32x4*)(ACT + (size_t)(row0 + r) * FF + f0) = pack8f(o);
            pa = ca; pb = cbv; ca = na; cbv = nb;
        }
    }
}
__device__ __forceinline__ void phase_qknorm(const bf16_t* QKV, const float* qn, const float* kn, const float* cosa, const float* sina, bf16_t* Qn, bf16_t* Kn, bf16_t* Vn, int bid, int G, int wave, int lane) {
    const int gw = bid * NWAVES + wave, NGW = G * NWAVES;
    for (int it = gw; it < MT * 6; it += NGW) {
        const int row = it / 6, sg = it % 6, s = sg * 4 + (lane >> 4), i = lane & 15, d0 = 8 * i;
        float x[8]; unpack8(*(const bf16x8*)(QKV + (size_t)row * NAIN + s * 128 + d0), x);
        float ss = 0.f;
#pragma unroll
        for (int j = 0; j < 8; ++j) ss += x[j] * x[j];
        ss += __shfl_xor(ss, 1); ss += __shfl_xor(ss, 2); ss += __shfl_xor(ss, 4); ss += __shfl_xor(ss, 8);
        const bool latent = row < ML;
        if (s < 20) {
            const float rstd = 1.0f / sqrtf(ss * (1.f / 128.f) + EPS); const float* nw = (s < 16 ? qn : kn) + d0;
#pragma unroll
            for (int j = 0; j < 8; ++j) x[j] = x[j] * rstd * nw[j];
            if (latent) { const int t = row & (SEQ - 1); const f32x4 cs = *(const f32x4*)(cosa + t * 64 + 4 * i), sn = *(const f32x4*)(sina + t * 64 + 4 * i);
#pragma unroll
                for (int p = 0; p < 4; ++p) { const float x1 = x[2 * p], x2 = x[2 * p + 1]; x[2 * p] = x1 * cs[p] - x2 * sn[p]; x[2 * p + 1] = x1 * sn[p] + x2 * cs[p]; } }
        }
        const u32x4 o = pack8f(x);
        if (s < 16) { if (latent) *(u32x4*)(Qn + (size_t)row * DM + s * 128 + d0) = o; }
        else { const int b = latent ? (row >> 11) : ((row - ML) >> 8), key = latent ? CTXL + (row & (SEQ - 1)) : ((row - ML) & (CTXL - 1));
            bf16_t* dst = (s < 20 ? Kn : Vn) + ((size_t)b * SKV + key) * 512 + (s & 3) * 128 + d0; *(u32x4*)dst = o; }
    }
}
__device__ __forceinline__ void phase_attention(const bf16_t* Qn, const bf16_t* Kn, const bf16_t* Vn, bf16_t* O, unsigned char* lds_generic, int bid, int G, int tid) {
    for (int u = bid; u < 512; u += G) {
        const int grp = (u & 7) * 2 + (u >> 8), slot = (u >> 3) & 31, b = grp >> 2, kvh = grp & 3, h = kvh * 4 + (slot >> 3), qb = slot & 7;
        const size_t qoff = ((size_t)b * SEQ + qb * 256) * DM + h * 128, koff = (size_t)b * SKV * 512 + kvh * 128;
        att::attn_dense_body((const att::bf16*)(Qn + qoff), (const att::bf16*)(Kn + koff), (const att::bf16*)(Vn + koff), (att::bf16*)(O + qoff), SKV, (char*)lds_generic, tid);
        __syncthreads();
    }
}

#define XB_TMO      128
#define XB_XCNT(j)  (256  + 64 * (j))
#define XB_XSUB(j)  (1280 + 64 * (j))
#define XB_XGEN(j)  (2304 + 64 * (j))
#define XB_TOP      3328
#define XB_TOPGEN   3392
#define XCD_BAR_WORDS 3456
#define XB_XSUB(j)  (1280 + 64 * (j))
#define XB_XGEN(j)  (2304 + 64 * (j))
#define XB_TOP      3328
#define XB_TOPGEN   3392
#define XCD_BAR_WORDS 3456
#define XB_SPIN_CAP (1u << 18)

__device__ __forceinline__ unsigned xb_ld(unsigned* p)              { return __hip_atomic_load(p, __ATOMIC_RELAXED, __HIP_MEMORY_SCOPE_AGENT); }
__device__ __forceinline__ unsigned xb_add(unsigned* p, unsigned v) { return __hip_atomic_fetch_add(p, v, __ATOMIC_RELAXED, __HIP_MEMORY_SCOPE_AGENT); }
__device__ __forceinline__ unsigned xb_xcc_id() { return (unsigned)__builtin_amdgcn_s_getreg((3 << 11) | 20) & 0xFu; }
#define XB_SPIN(cond, bar) do { unsigned _sp = 0; while (cond) { __builtin_amdgcn_s_sleep(1); \
    if ((++_sp & 255u) == 0u) { if (xb_ld(&(bar)[XB_TMO])) break; if (_sp > XB_SPIN_CAP) { atomicAdd(&(bar)[XB_TMO], 1u); break; } } } } while (0)

struct XcdBarrier {
    unsigned* bar; unsigned x;
    volatile LAS unsigned* st;
};

__device__ __forceinline__ XcdBarrier xcd_barrier_post(unsigned* bar, volatile LAS unsigned* st) {
    XcdBarrier b; b.bar = bar; b.x = xb_xcc_id(); b.st = st;
    if (threadIdx.x == 0) (void)xb_add(&bar[XB_XCNT(b.x)], 1u);
    return b;
}
__device__ __forceinline__ void xcd_barrier_complete(unsigned* bar, unsigned x, unsigned& nloc, unsigned& nx) {
    const unsigned G = gridDim.x * gridDim.y * gridDim.z;
    unsigned sum, cnt, mine, sp = 0u;
    for (;;) {
        sum = 0u; cnt = 0u; mine = 0u;
#pragma unroll
        for (unsigned j = 0; j < 16; ++j) { const unsigned c = xb_ld(&bar[XB_XCNT(j)]); sum += c; cnt += (c > 0u) ? 1u : 0u; mine = (j == x) ? c : mine; }
        if (sum == G) break;
        __builtin_amdgcn_s_sleep(1);
        if ((++sp & 255u) == 0u) { if (xb_ld(&bar[XB_TMO])) break; if (sp > XB_SPIN_CAP) { atomicAdd(&bar[XB_TMO], 1u); break; } }
    }
    nloc = mine > 0u ? mine : 1u; nx = cnt > 0u ? cnt : 1u;
}

__device__ __forceinline__ void xcd_barrier(const XcdBarrier& b) {
    asm volatile("s_waitcnt vmcnt(0)" ::: "memory");
    __syncthreads();
    if (threadIdx.x == 0) {
        unsigned* bar = b.bar;
        __builtin_amdgcn_s_waitcnt(0);
        unsigned nloc = b.st[0], nx = b.st[1];
        if (nloc == 0u) { xcd_barrier_complete(bar, b.x, nloc, nx); b.st[0] = nloc; b.st[1] = nx; }
        const unsigned old = xb_add(&bar[XB_XSUB(b.x)], 1u);
        const unsigned gen = old / nloc;
        if (old + 1u == (gen + 1u) * nloc) {
            __builtin_amdgcn_fence(__ATOMIC_RELEASE, "agent");
            asm volatile("s_waitcnt vmcnt(0)" ::: "memory");
            const unsigned og = xb_add(&bar[XB_TOP], 1u);
            const unsigned tg = og / nx;
            if (og + 1u == (tg + 1u) * nx) xb_add(&bar[XB_TOPGEN], 1u);
            else XB_SPIN(xb_ld(&bar[XB_TOPGEN]) == tg, bar);
            __builtin_amdgcn_fence(__ATOMIC_ACQUIRE, "agent");
            xb_add(&bar[XB_XGEN(b.x)], 1u);
            asm volatile("s_waitcnt vmcnt(0)" ::: "memory");
        } else {
            XB_SPIN(xb_ld(&bar[XB_XGEN(b.x)]) == gen, bar);
            __builtin_amdgcn_fence(__ATOMIC_ACQUIRE, "agent");
            asm volatile("s_waitcnt vmcnt(0)" ::: "memory");
        }
    }
    __syncthreads();
}

__global__ void __launch_bounds__(NTHR, 2) mega(Args a) {
    extern __shared__ __attribute__((aligned(16))) unsigned char lds_raw[];
    LAS unsigned char* lds = (LAS unsigned char*)lds_raw;
    cg::grid_group grid = cg::this_grid();
    const int bid = blockIdx.x, G = gridDim.x;
    unsigned char* ws = a.ws;
    const float* MOD = (const float*)(ws + WS_MOD);
    float* XS = (float*)(ws + WS_XS); bf16_t* H = (bf16_t*)(ws + WS_H);
    unsigned char* R1 = ws + WS_R1; unsigned char* R2 = ws + WS_R2;
    volatile LAS unsigned* bst = (volatile LAS unsigned*)(lds + BAR_LDS_OFF);
    if (threadIdx.x < 2) bst[threadIdx.x] = 0u;
    __syncthreads();
    XcdBarrier xbar; xbar.bar = (unsigned*)(ws + WS_CTL); xbar.x = 0; xbar.st = nullptr;
    if (a.ph_hi - a.ph_lo > 1) xbar = xcd_barrier_post((unsigned*)(ws + WS_CTL), bst);
    auto run = [&](auto PC) {
        constexpr int p = decltype(PC)::value;
        int tid = threadIdx.x; asm volatile("" : "+v"(tid));
        const int lane = tid & 63, wave = __builtin_amdgcn_readfirstlane(tid >> 6);
        const int layer = p >= 10 ? 1 : 0;
        const float* mod = MOD + (size_t)layer * 5 * 12288;
        switch (PHSEL(p)) {
        case 0: phase_prologue(a, ws, lds, bid, G, tid, wave, lane); break;
        case 1: phase_norm(a.in[I_X], a.in[I_CTX], a.in[I_NORMW] + 0 * DM, mod, 0, H, MT, nullptr, XS, bid, G, wave, lane); break;
        case 6: phase_norm(XS, a.in[I_CTX], a.in[I_NORMW] + 1 * DM, mod, 3 * DM, H, MT, (const float*)R1, XS, bid, G, wave, lane); break;
        case 10: phase_norm(XS, XS + (size_t)ML * DM, a.in[I_NORMW] + 2 * DM, mod, 0, H, MT, (const float*)R1, XS, bid, G, wave, lane); break;
        case 15: phase_norm(XS, XS + (size_t)ML * DM, a.in[I_NORMW] + 3 * DM, mod, 3 * DM, H, ML, nullptr, XS, bid, G, wave, lane); break;
        case 2: {
            pg8::Gemm g{H, (const bf16_t*)(ws + WS_WRIN), MT, NRIN, DM}; pg8::StaticOrder S; S.init(MT, NRIN, DM, G, bid);
            pg8::EpiRow8<pg8::FRope> E{{(bf16_t*)(R1 + R1_Q), (bf16_t*)(R1 + R1_K), (bf16_t*)(R1 + R1_V), (bf16_t*)(R1 + R1_G), (const float*)(ws + WS_ROPER), (const float*)(ws + WS_ROPER) + 2048 * 128, ML}};
            pg8::gemm_phase<pg8::EpiRow8<pg8::FRope>, pg8::StaticOrder, true, true>(lds, g, S, E, tid);
            { const int rem = S.nwg % G; convert_jobs(1, a, ws, lds, rem ? (bid >= rem ? bid - rem : -1) : bid, rem ? G - rem : G, wave, lane); }
        } break;
        case 3: phase_retention((const bf16_t*)(R1 + R1_Q), (const bf16_t*)(R1 + R1_K), (const bf16_t*)(R1 + R1_V), (bf16_t*)R2, a.in[I_RLD], lds, bid, G, tid, wave, lane); break;
        case 4: phase_combine((const bf16_t*)R2, (const bf16_t*)(R1 + R1_G), a.in[I_RGN], (bf16_t*)(R1 + R1_V), bid, G, wave, lane); break;
        case 5: case 9: case 14: case 18: {
            const bf16_t* A; const bf16_t* Bt; int M, K; const float* bx; const float* bc; int goff;
            if (p == 5)       { A = (const bf16_t*)(R1 + R1_V); Bt = (const bf16_t*)(ws + WS_WROUT); M = MT; K = 2 * DM; bx = a.in[I_X]; bc = a.in[I_CTX]; goff = 2 * DM; }
            else if (p == 9)  { A = (const bf16_t*)R2; Bt = (const bf16_t*)(ws + WS_WDN); M = MT; K = FF; bx = XS; bc = XS + (size_t)ML * DM; goff = 5 * DM; }
            else if (p == 14) { A = (const bf16_t*)(R1 + R1_O); Bt = (const bf16_t*)(ws + WS_WAOUT); M = ML; K = DM; bx = XS; bc = XS + (size_t)ML * DM; goff = 2 * DM; }
            else              { A = (const bf16_t*)R2; Bt = (const bf16_t*)(ws + WS_WDN) + (size_t)DM * FF; M = ML; K = FF; bx = XS; bc = XS + (size_t)ML * DM; goff = 5 * DM; }
            pg8::Gemm g{A, Bt, M, DM, K};
            pg8::EpiRow8<pg8::FRes> E{{bx, bc, XS, mod + goff, ML, (float*)R1}};
            if constexpr (p == 5 || p == 9) { pg8::SplitOrder S; S.init(K, G, bid); pg8::gemm_phase<pg8::EpiRow8<pg8::FRes>, pg8::SplitOrder, true, true>(lds, g, S, E, tid); }
            else { pg8::StaticOrder S; S.init(M, DM, K, G, bid); pg8::gemm_phase<pg8::EpiRow8<pg8::FRes>, pg8::StaticOrder, true, true>(lds, g, S, E, tid); }
        } break;
        case 7: case 11: case 16: {
            const bf16_t* Bt; int M, N; bf16_t* O;
            if (p == 7)       { Bt = (const bf16_t*)(ws + WS_WUP); M = MT; N = FF2; O = (bf16_t*)R1; }
            else if (p == 11) { Bt = (const bf16_t*)(ws + WS_WAIN); M = MT; N = NAIN; O = (bf16_t*)R2; }
            else              { Bt = (const bf16_t*)(ws + WS_WUP) + (size_t)FF2 * DM; M = ML; N = FF2; O = (bf16_t*)R1; }
            pg8::Gemm g{H, Bt, M, N, DM}; pg8::StaticOrder S; S.init(M, N, DM, G, bid);
            pg8::EpiRow8<pg8::FPlain> E{{O, N}};
            pg8::gemm_phase<pg8::EpiRow8<pg8::FPlain>, pg8::StaticOrder, true, true>(lds, g, S, E, tid);
            if constexpr (p == 7) { const int rem = S.nwg % G; convert_jobs(2, a, ws, lds, rem ? (bid >= rem ? bid - rem : -1) : bid, rem ? G - rem : G, wave, lane); }
        } break;
        case 8: phase_conv((const bf16_t*)R1, a.in[I_FCW], a.in[I_FCB], (bf16_t*)R2, MT, bid, G, tid); break;
        case 17: phase_conv((const bf16_t*)R1, a.in[I_FCW] + 3 * FF2, a.in[I_FCB] + FF2, (bf16_t*)R2, ML, bid, G, tid); break;
        case 12: phase_qknorm((const bf16_t*)R2, a.in[I_AQN], a.in[I_AKN], (const float*)(ws + WS_ROPEA), (const float*)(ws + WS_ROPEA) + 2048 * 64,
                              (bf16_t*)(R1 + R1_QN), (bf16_t*)(R1 + R1_KN), (bf16_t*)(R1 + R1_VN), bid, G, wave, lane); break;
        case 13: phase_attention((const bf16_t*)(R1 + R1_QN), (const bf16_t*)(R1 + R1_KN), (const bf16_t*)(R1 + R1_VN), (bf16_t*)(R1 + R1_O), lds_raw, bid, G, tid); break;
        case 19: phase_final(XS, a.in[I_FNW], a.out, bid, G, wave, lane); break;
        default: break;
        }
    };
    unsigned long long tp0 = 0, tp1 = 0;
#define RUNP(P) if (a.ph_lo <= (P) && (P) < a.ph_hi) { if ((P) == TIME_PHASE) tp0 = __builtin_amdgcn_s_memrealtime(); run(std::integral_constant<int, (P)>{}); if ((P) + 1 < a.ph_hi) { if (USE_CG_SYNC) grid.sync(); else xcd_barrier(xbar); } if ((P) == TIME_PHASE) tp1 = __builtin_amdgcn_s_memrealtime(); }
    RUNP(0) RUNP(1) RUNP(2) RUNP(3) RUNP(4) RUNP(5) RUNP(6) RUNP(7) RUNP(8) RUNP(9) RUNP(10) RUNP(11) RUNP(12) RUNP(13) RUNP(14) RUNP(15) RUNP(16) RUNP(17) RUNP(18) RUNP(19)
#undef RUNP
    if (TIME_PHASE >= 0 && bid == 0 && threadIdx.x == 0) { const unsigned long long tgt = (tp1 - tp0) * TIME_SCALE, ts = __builtin_amdgcn_s_memrealtime(); while (__builtin_amdgcn_s_memrealtime() - ts < tgt) __builtin_amdgcn_s_sleep(32); }
}

extern "C" void kernel_launch(void* const* d_in, const int* in_sizes, int n_in, void* d_out, int out_size, void* d_ws, size_t ws_size, hipStream_t stream) {
    static int grid = 0;
    if (grid == 0) {
        if (n_in != 20 || out_size != ML * DM || ws_size < WS_END) { fprintf(stderr, "kernel_launch: unexpected shapes: n_in %d out %d ws %zu (need %zu)\n", n_in, out_size, ws_size, (size_t)WS_END); grid = -1; return; }
        int dev = 0, cus = 0, per_cu = 0;
        hipGetDevice(&dev); hipDeviceGetAttribute(&cus, hipDeviceAttributeMultiprocessorCount, dev);
        if (hipFuncSetAttribute((const void*)mega, hipFuncAttributeMaxDynamicSharedMemorySize, LDS_BYTES) != hipSuccess) { fprintf(stderr, "kernel_launch: hipFuncSetAttribute failed\n"); grid = -1; return; }
        hipOccupancyMaxActiveBlocksPerMultiprocessor(&per_cu, (const void*)mega, NTHR, LDS_BYTES);
        if (per_cu < 1) { fprintf(stderr, "kernel_launch: occupancy query says %d blocks per CU\n", per_cu); per_cu = 1; }
        (void)hipGetLastError();
        grid = cus * 1;
        fprintf(stderr, "kernel_launch: grid %d (cus %d, per_cu %d), ws %zu need %zu\n", grid, cus, per_cu, ws_size, (size_t)WS_END);
    }
    if (grid < 0) return;
    Args a{};
    for (int i = 0; i < 20; ++i) a.in[i] = (const float*)d_in[i];
    a.out = (float*)d_out; a.ws = (unsigned char*)d_ws;
    if (hipMemsetAsync((char*)d_ws + WS_CTL, 0, WS_ROPER, stream) != hipSuccess) { fprintf(stderr, "kernel_launch: memset failed\n"); return; }
#if ONE_LAUNCH
    a.ph_lo = 0; a.ph_hi = NPH;
    void* args[] = {&a};
    hipError_t e = hipLaunchCooperativeKernel((const void*)mega, dim3(grid), dim3(NTHR), args, LDS_BYTES, stream);
    if (e != hipSuccess) fprintf(stderr, "kernel_launch: cooperative launch failed: %s (grid %d)\n", hipGetErrorString(e), grid);
#else
    for (int p = 0; p < NPH; ++p) { a.ph_lo = p; a.ph_hi = p + 1; hipLaunchKernelGGL(mega, dim3(grid), dim3(NTHR), LDS_BYTES, stream, a); }
    const hipError_t le = hipPeekAtLastError();
    if (le != hipSuccess) fprintf(stderr, "kernel_launch: launch failed: %s\n", hipGetErrorName(le));
#endif
}
```

```cpp
#include <hip/hip_runtime.h>
#include <hip/hip_bf16.h>
#include <hip/hip_cooperative_groups.h>
#include <cstdio>
#include <cstdint>
#include <cmath>
#include <type_traits>
namespace cg = cooperative_groups;
#ifndef ONE_LAUNCH
#define ONE_LAUNCH 1
#endif
#ifndef TIME_PHASE
#define TIME_PHASE -1
#endif
#define TIME_SCALE 4
#ifndef USE_CG_SYNC
#define USE_CG_SYNC 0
#endif
namespace pg8 {
#define PG8_LAS __attribute__((address_space(3)))
typedef unsigned short bf16_t;
typedef short bf16x8 __attribute__((ext_vector_type(8)));
typedef float f32x4 __attribute__((ext_vector_type(4)));
typedef unsigned u32x4 __attribute__((ext_vector_type(4)));
constexpr int BM = 256, BK = 64, HALF = 128, HTB = HALF * BK * 2  , STAGE_BYTES = 8 * HTB, NXCD = 8, WGM = 8;

__host__ __device__ __forceinline__ int lds_byte(int r, int c) { const int st = (r >> 4) * 2 + (c >> 5), rr = r & 15, cc = c & 31, ob = rr * 64 + cc * 2; return st * 1024 + (ob ^ (((ob >> 9) & 1) << 5)); }
__host__ __device__ __forceinline__ void stage_rc(int b, int& R, int& C) { const int st = b / 1024, sb = b % 1024, swz = sb ^ (((sb >> 9) & 1) << 5); R = (st >> 1) * 16 + swz / 64; C = (st & 1) * 32 + (swz % 64) / 2; }
__host__ __device__ __forceinline__ int perm32(int rho) { const int n = rho >> 4, i = rho & 15; return 8 * (i >> 2) + 4 * n + (i & 3); }

struct Unit { int pm, pn, kt0, nt, aux; };
struct Gemm { const bf16_t* A; const bf16_t* Bt; int M, N, K; };

struct StaticOrder {
    int nM, nN, nwg, G, c, ntk;
    __host__ __device__ void init(int M, int N, int K, int G_, int c_) { nM = M / BM; nN = N / BM; nwg = nM * nN; G = G_; c = c_; ntk = K / BK; }
    __host__ __device__ __forceinline__ bool next(int i, Unit& u) const {
        const long L = (long)i * G + c; if (L >= nwg) return false;
        int wgid = (int)L; { const int q = nwg / NXCD, r = nwg % NXCD, xcd = wgid % NXCD, off = wgid / NXCD; wgid = (xcd < r ? xcd * (q + 1) : r * (q + 1) + (xcd - r) * q) + off; }
        const int nig = WGM * nN, gid = wgid / nig, fm = gid * WGM, gsz = (nM - fm) < WGM ? (nM - fm) : WGM;
        u.pm = fm + ((wgid % nig) % gsz); u.pn = (wgid % nig) / gsz; u.kt0 = 0; u.nt = ntk; u.aux = -1; return true;
    }
    __device__ __forceinline__ void a_ready(const Unit&) const {}
    __device__ __forceinline__ void done(const Unit&) const {}
};

__device__ __forceinline__ unsigned cvt_pk_bf16(float lo, float hi) { unsigned r; asm volatile("v_cvt_pk_bf16_f32 %0, %1, %2" : "=v"(r) : "v"(lo), "v"(hi)); return r; }
typedef float f32x2 __attribute__((ext_vector_type(2)));
struct SplitOrder {
    StaticOrder lat; int G, c, e, extra;
    __host__ __device__ void init(int K, int G_, int c_) { lat.init(8192, 2048, K, G_, c_); G = G_; c = c_; const int ntk = K / BK; e = (ntk / 8) & ~1; extra = (ntk - 8 * e) / 2; }
    __host__ __device__ __forceinline__ bool next(int i, Unit& u) const {
        const int item = c + i * G; if (item >= 512) return false;
        const bool ctx = item < 256;
        Unit l; StaticOrder t = lat; t.c = ctx ? 0 : item - 256; t.G = 0; t.next(0, l);
        const int cu = item >> 3, sl = item & 7;
        Unit r;
        r.pm = ctx ? 32 + (cu >> 3) : l.pm; r.pn = ctx ? (cu & 7) : l.pn; r.nt = ctx ? e + (sl < extra ? 2 : 0) : l.nt; r.kt0 = ctx ? e * sl + 2 * (sl < extra ? sl : extra) : 0; r.aux = ctx ? item : -1;
        u = r; return true;
    }
    __device__ __forceinline__ void a_ready(const Unit&) const {}
    __device__ __forceinline__ void done(const Unit&) const {}
};

template <class F> struct EpiRow8 {
    static constexpr bool PERM = true, AFTER_DRAIN = false; F f;
    __device__ __forceinline__ void operator()(const f32x4 (&acc)[2][2][4][2], const Unit& u, int wr, int wc, int fr, int fq) const {
        const int row0 = u.pm * BM + wr * 64 + fr, col0 = u.pn * BM + wc * 32 + 8 * fq;
#pragma unroll
        for (int ai = 0; ai < 2; ++ai)
#pragma unroll
            for (int m = 0; m < 4; ++m)
#pragma unroll
                for (int bj = 0; bj < 2; ++bj) f.apply(u, row0 + ai * HALF + m * 16, col0 + bj * HALF, acc[ai][bj][m][0], acc[ai][bj][m][1]);
    }
};
__device__ __forceinline__ u32x4 pack8(const f32x4 a, const f32x4 b) { u32x4 w; w.x = cvt_pk_bf16(a[0], a[1]); w.y = cvt_pk_bf16(a[2], a[3]); w.z = cvt_pk_bf16(b[0], b[1]); w.w = cvt_pk_bf16(b[2], b[3]); return w; }
struct FPlain {
    bf16_t* O; int ldc;
    __device__ __forceinline__ void apply(const Unit&, int row, int col, f32x4 v0, f32x4 v1) const { *(u32x4*)(O + (size_t)row * ldc + col) = pack8(v0, v1); }
};
struct FRope {
    bf16_t *Q, *K, *V, *G; const float* cosr; const float* sinr; int ML;
    __device__ __forceinline__ void apply(const Unit&, int row, int col, f32x4 v0, f32x4 v1) const {
        if (col < 4096) {
            const bool isk = col >= 2048; const int c = col & 2047;
            if (isk) { v0 = v0 * 0.0625f; v1 = v1 * 0.0625f; }
            if (row < ML) {
                const int t = row & 2047, pi = (c & 255) >> 1;
                const f32x4 cs = *(const f32x4*)(cosr + t * 128 + pi), sn = *(const f32x4*)(sinr + t * 128 + pi);
                f32x4 a, b;
                a[0] = v0[0] * cs[0] - v0[1] * sn[0]; a[1] = v0[0] * sn[0] + v0[1] * cs[0];
                a[2] = v0[2] * cs[1] - v0[3] * sn[1]; a[3] = v0[2] * sn[1] + v0[3] * cs[1];
                b[0] = v1[0] * cs[2] - v1[1] * sn[2]; b[1] = v1[0] * sn[2] + v1[1] * cs[2];
                b[2] = v1[2] * cs[3] - v1[3] * sn[3]; b[3] = v1[2] * sn[3] + v1[3] * cs[3];
                v0 = a; v1 = b;
            }
            *(u32x4*)((isk ? K : Q) + (size_t)row * 2048 + c) = pack8(v0, v1);
        } else if (col < 8192) { *(u32x4*)(V + (size_t)row * 4096 + (col - 4096)) = pack8(v0, v1); }
        else { *(u32x4*)(G + (size_t)row * 4096 + (col - 8192)) = pack8(v0, v1); }
    }
};
struct FRes {
    const float* baseX; const float* baseC; float* XS; const float* gate; int ML; float* slab;
    __device__ __forceinline__ void apply(const Unit& u, int row, int col, f32x4 v0, f32x4 v1) const {
        const int mr = row < ML ? (row >> 11) : 4;
        const float* gp = gate + mr * 12288 + col;
        const f32x4 g0 = *(const f32x4*)gp, g1 = *(const f32x4*)(gp + 4);
        if (u.aux >= 0) { float* o = slab + ((size_t)u.aux * 256 + (row & 255)) * 256 + (col & 255); *(f32x4*)o = g0 * v0; *(f32x4*)(o + 4) = g1 * v1; return; }
        const float* b = (row < ML ? baseX + (size_t)row * 2048 : baseC + (size_t)(row - ML) * 2048) + col;
        const f32x4 b0 = *(const f32x4*)b, b1 = *(const f32x4*)(b + 4);
        float* o = XS + (size_t)row * 2048 + col;
        *(f32x4*)o = b0 + g0 * v0; *(f32x4*)(o + 4) = b1 + g1 * v1;
    }
};
__device__ __forceinline__ float dpp_ror1(float v)  { return __builtin_bit_cast(float, __builtin_amdgcn_update_dpp(0, __builtin_bit_cast(int, v), 0x121, 0xf, 0xf, false)); }
__device__ __forceinline__ float dpp_ror15(float v) { return __builtin_bit_cast(float, __builtin_amdgcn_update_dpp(0, __builtin_bit_cast(int, v), 0x12f, 0xf, 0xf, false)); }
__device__ __forceinline__ f32x4 dpp_prev(f32x4 v) { return (f32x4){dpp_ror1(v[0]), dpp_ror1(v[1]), dpp_ror1(v[2]), dpp_ror1(v[3])}; }
__device__ __forceinline__ f32x4 dpp_next(f32x4 v) { return (f32x4){dpp_ror15(v[0]), dpp_ror15(v[1]), dpp_ror15(v[2]), dpp_ror15(v[3])}; }
__device__ __forceinline__ float silu1(float x) { return x / (1.f + __expf(-x)); }
struct EpiConv {
    static constexpr bool PERM = true, AFTER_DRAIN = false;
    bf16_t* ACT; const float* cw; const float* cb; float* HP; float* HU; int FFN;
    __device__ __forceinline__ void operator()(const f32x4 (&acc)[2][2][4][2], const Unit& u, int wr, int wc, int fr, int fq) const {
        const int FF2_ = 2 * FFN;
        const f32x4 z = (f32x4){0.f, 0.f, 0.f, 0.f};
#pragma unroll
        for (int n = 0; n < 2; ++n) {
            const int f = u.pn * HALF + wc * 32 + 8 * fq + 4 * n;
            const float* wA = cw + f; const float* wB = cw + FFN + f;
            const f32x4 wa0 = *(const f32x4*)wA, wa1 = *(const f32x4*)(wA + FF2_), wa2 = *(const f32x4*)(wA + 2 * FF2_), ba = *(const f32x4*)(cb + f);
            const f32x4 wb0 = *(const f32x4*)wB, wb1 = *(const f32x4*)(wB + FF2_), wb2 = *(const f32x4*)(wB + 2 * FF2_), bb = *(const f32x4*)(cb + FFN + f);
#pragma unroll
            for (int ai = 0; ai < 2; ++ai) {
                const int rowb = u.pm * BM + ai * HALF + wr * 64;
                f32x4 carry_a = z, carry_b = z;
#pragma unroll
                for (int m = 0; m < 4; ++m) {
                    const f32x4 xa = acc[ai][0][m][n], xb = acc[ai][1][m][n];
                    const f32x4 pva = dpp_prev(xa), pvb = dpp_prev(xb);
                    const f32x4 nxa = dpp_next(xa), nxb = dpp_next(xb);
                    const f32x4 nna = m < 3 ? dpp_next(acc[ai][0][m < 3 ? m + 1 : 3][n]) : z, nnb = m < 3 ? dpp_next(acc[ai][1][m < 3 ? m + 1 : 3][n]) : z;
                    const f32x4 pa = fr > 0 ? pva : carry_a, pb = fr > 0 ? pvb : carry_b, na = fr < 15 ? nxa : nna, nb = fr < 15 ? nxb : nnb;
                    const f32x4 ca = ba + wa0 * pa + wa1 * xa + wa2 * na;
                    const f32x4 cbv = bb + wb0 * pb + wb1 * xb + wb2 * nb;
                    carry_a = pva; carry_b = pvb;
                    const int row = rowb + 16 * m + fr;
                    const bool first = (m == 0) && (fr == 0), last = (m == 3) && (fr == 15);
                    if (first || last) {
                        const size_t h = (size_t)(2 * (row >> 6) + (last ? 1 : 0)) * 2 * FFN + f;
                        *(f32x4*)(HP + h) = ca; *(f32x4*)(HP + h + FFN) = cbv; *(f32x4*)(HU + h) = xa; *(f32x4*)(HU + h + FFN) = xb;
                    } else {
                        typedef unsigned u32x2_ __attribute__((ext_vector_type(2)));
                        u32x2_ w; w.x = cvt_pk_bf16(silu1(ca[0]) * cbv[0], silu1(ca[1]) * cbv[1]); w.y = cvt_pk_bf16(silu1(ca[2]) * cbv[2], silu1(ca[3]) * cbv[3]);
                        *(u32x2_*)(ACT + (size_t)row * FFN + f) = w;
                    }
                }
            }
        }
    }
};
template <class Epi, class Sched, bool ALIGN_EPI = false, bool SP2 = false>
__device__ __forceinline__ void gemm_phase(PG8_LAS unsigned char* lds, const Gemm g, const Sched& S, const Epi& E, const int tid) {
    const int wid = __builtin_amdgcn_readfirstlane(tid >> 6), lane = tid & 63, wr = wid >> 2, wc = wid & 3, fr = lane & 15, fq = lane >> 4;
    const int K = g.K;
    unsigned voffA[2], voffB[2];
#pragma unroll
    for (int i = 0; i < 2; ++i) { int R, C; stage_rc(tid * 16 + i * 8192, R, C); const int Rb = Epi::PERM ? ((R & ~31) + perm32(R & 31)) : R;
        voffA[i] = (unsigned)(R * K + C) * 2u; voffB[i] = (unsigned)(Rb * K + C) * 2u; }
    const size_t kstep = (size_t)(BK * 2);
    const size_t hstep = (size_t)HALF * K * 2;
    const size_t tstep = 2 * hstep;
    const unsigned ldsw = (unsigned)wid * 1024u;
    const int aoff = lds_byte(wr * 64 + fr, fq * 8), boff = lds_byte(wc * 32 + fr, fq * 8);
#define PG8_SA(b, h) (((b) * 2 + (h)) * HTB)
#define PG8_SB(b, h) ((4 + (b) * 2 + (h)) * HTB)
#define PG8_STAGE(bufoff, gbase, voff) do { _Pragma("unroll") for (int _i = 0; _i < 2; ++_i) \
        __builtin_amdgcn_global_load_lds((const unsigned*)((const char*)(gbase) + (voff)[_i]), (PG8_LAS unsigned*)(lds + (bufoff) + ldsw + _i * 8192), 16, 0, 0); } while (0)
#define PG8_LDA(dst, b, h) do { _Pragma("unroll") for (int m = 0; m < 4; ++m) _Pragma("unroll") for (int k = 0; k < 2; ++k) dst[m][k] = *(const PG8_LAS bf16x8*)(lds + PG8_SA(b, h) + aoff + m * 2048 + k * 1024); } while (0)
#define PG8_LDB(dst, b, h) do { _Pragma("unroll") for (int n = 0; n < 2; ++n) _Pragma("unroll") for (int k = 0; k < 2; ++k) dst[n][k] = *(const PG8_LAS bf16x8*)(lds + PG8_SB(b, h) + boff + n * 2048 + k * 1024); } while (0)
#define PG8_MMA(ai, bj, At, Bt) do { __builtin_amdgcn_s_setprio(1); _Pragma("unroll") for (int m = 0; m < 4; ++m) _Pragma("unroll") for (int n = 0; n < 2; ++n) _Pragma("unroll") for (int k = 0; k < 2; ++k) \
        acc[ai][bj][m][n] = __builtin_amdgcn_mfma_f32_16x16x32_bf16(Bt[n][k], At[m][k], acc[ai][bj][m][n], 0, 0, 0); __builtin_amdgcn_s_setprio(0); } while (0)
#define PG8_WAIT_V(n) asm volatile("s_waitcnt vmcnt(" #n ")" ::: "memory")
#define PG8_WAIT_L(n) asm volatile("s_waitcnt lgkmcnt(" #n ")" ::: "memory")
#define PG8_BAR __builtin_amdgcn_s_barrier()
#define PG8_SCHED __builtin_amdgcn_sched_barrier(0)
    Unit cur, nxt; int ui = 0;
    if (!S.next(0, cur)) return;
    f32x4 acc[2][2][4][2];
#pragma unroll
    for (int a = 0; a < 2; ++a)
#pragma unroll
        for (int b = 0; b < 2; ++b)
#pragma unroll
            for (int m = 0; m < 4; ++m)
#pragma unroll
                for (int n = 0; n < 2; ++n) acc[a][b][m][n] = (f32x4){0.f, 0.f, 0.f, 0.f};
    bf16x8 At[4][2], B0[2][2], B1[2][2];
    const char* cA = (const char*)g.A + (size_t)cur.pm * tstep + (size_t)cur.kt0 * kstep; const char* cB = (const char*)g.Bt + (size_t)cur.pn * tstep + (size_t)cur.kt0 * kstep;
    S.a_ready(cur);
    if constexpr (SP2) {
        PG8_STAGE(PG8_SB(0, 0), cB, voffB); PG8_STAGE(PG8_SB(0, 1), cB + hstep, voffB); PG8_STAGE(PG8_SA(0, 0), cA, voffA); PG8_STAGE(PG8_SA(0, 1), cA + hstep, voffA);
        if (wr == 1) PG8_BAR;
        PG8_WAIT_V(2); PG8_BAR;
        PG8_STAGE(PG8_SB(1, 0), cB + kstep, voffB); PG8_STAGE(PG8_SA(1, 0), cA + kstep, voffA); PG8_STAGE(PG8_SB(1, 1), cB + hstep + kstep, voffB);
        PG8_WAIT_V(6); PG8_BAR;
    } else {
        PG8_STAGE(PG8_SB(0, 0), cB, voffB); PG8_STAGE(PG8_SA(0, 0), cA, voffA); PG8_STAGE(PG8_SB(0, 1), cB + hstep, voffB); PG8_STAGE(PG8_SA(0, 1), cA + hstep, voffA);
        if (wr == 1) PG8_BAR;
        PG8_WAIT_V(4); PG8_BAR;
        PG8_STAGE(PG8_SB(1, 0), cB + kstep, voffB); PG8_STAGE(PG8_SA(1, 0), cA + kstep, voffA); PG8_STAGE(PG8_SB(1, 1), cB + hstep + kstep, voffB);
        PG8_WAIT_V(6); PG8_BAR;
    }
    for (;;) {
        const bool has_next = S.next(ui + 1, nxt);
        const char* nA = has_next ? (const char*)g.A + (size_t)nxt.pm * tstep + (size_t)nxt.kt0 * kstep : cA; const char* nB = has_next ? (const char*)g.Bt + (size_t)nxt.pn * tstep + (size_t)nxt.kt0 * kstep : cB;
        const int nt = cur.nt;
        for (int t = 0; t < nt; t += 2) {
            const bool last = (t == nt - 2);
            const char* a1 = cA + (size_t)(t + 1) * kstep;
            const char* a2 = last ? nA : cA + (size_t)(t + 2) * kstep; const char* b2 = last ? nB : cB + (size_t)(t + 2) * kstep;
            const char* a3 = a2 + kstep; const char* b3 = b2 + kstep;
            if (last && has_next) S.a_ready(nxt);
            if constexpr (SP2) {
            PG8_LDB(B0, 0, 0); PG8_LDB(B1, 0, 1); PG8_SCHED; PG8_LDA(At, 0, 0); PG8_STAGE(PG8_SA(1, 1), a1 + hstep, voffA);
            PG8_WAIT_V(8); PG8_WAIT_L(0); PG8_BAR; PG8_MMA(0, 0, At, B0); PG8_MMA(0, 1, At, B1); PG8_BAR; PG8_SCHED;
            PG8_LDA(At, 0, 1); PG8_STAGE(PG8_SB(0, 0), b2, voffB); PG8_STAGE(PG8_SB(0, 1), b2 + hstep, voffB); PG8_STAGE(PG8_SA(0, 0), a2, voffA);
            PG8_WAIT_V(8); PG8_WAIT_L(0); PG8_BAR; PG8_MMA(1, 0, At, B0); PG8_MMA(1, 1, At, B1); PG8_BAR; PG8_SCHED;
            PG8_LDB(B0, 1, 0); PG8_LDB(B1, 1, 1); PG8_SCHED; PG8_LDA(At, 1, 0); PG8_STAGE(PG8_SA(0, 1), a2 + hstep, voffA);
            PG8_WAIT_V(8); PG8_WAIT_L(0); PG8_BAR; PG8_MMA(0, 0, At, B0); PG8_MMA(0, 1, At, B1); PG8_BAR; PG8_SCHED;
            PG8_LDA(At, 1, 1); PG8_STAGE(PG8_SB(1, 0), b3, voffB); PG8_STAGE(PG8_SB(1, 1), b3 + hstep, voffB); PG8_STAGE(PG8_SA(1, 0), a3, voffA);
            PG8_WAIT_V(8); PG8_WAIT_L(0); PG8_BAR; PG8_MMA(1, 0, At, B0); PG8_MMA(1, 1, At, B1); PG8_BAR; PG8_SCHED;
            } else {
            PG8_LDB(B0, 0, 0); PG8_SCHED; PG8_LDA(At, 0, 0); PG8_STAGE(PG8_SA(1, 1), a1 + hstep, voffA);
            PG8_WAIT_L(8); PG8_BAR; PG8_WAIT_L(0); PG8_MMA(0, 0, At, B0); PG8_BAR; PG8_SCHED;
            PG8_LDB(B1, 0, 1); PG8_STAGE(PG8_SB(0, 0), b2, voffB);
            PG8_BAR; PG8_WAIT_L(0); PG8_MMA(0, 1, At, B1); PG8_BAR;
            PG8_LDA(At, 0, 1); PG8_STAGE(PG8_SA(0, 0), a2, voffA);
            PG8_BAR; PG8_WAIT_L(0); PG8_MMA(1, 0, At, B0); PG8_BAR; PG8_SCHED;
            PG8_STAGE(PG8_SB(0, 1), b2 + hstep, voffB);
            PG8_WAIT_V(6); PG8_BAR; PG8_MMA(1, 1, At, B1); PG8_BAR;
            PG8_LDB(B0, 1, 0); PG8_SCHED; PG8_LDA(At, 1, 0); PG8_STAGE(PG8_SA(0, 1), a2 + hstep, voffA);
            PG8_WAIT_L(8); PG8_BAR; PG8_WAIT_L(0); PG8_MMA(0, 0, At, B0); PG8_BAR; PG8_SCHED;
            PG8_LDB(B1, 1, 1); PG8_STAGE(PG8_SB(1, 0), b3, voffB);
            PG8_BAR; PG8_WAIT_L(0); PG8_MMA(0, 1, At, B1); PG8_BAR;
            PG8_LDA(At, 1, 1); PG8_STAGE(PG8_SA(1, 0), a3, voffA);
            PG8_BAR; PG8_WAIT_L(0); PG8_MMA(1, 0, At, B0); PG8_BAR; PG8_SCHED;
            PG8_STAGE(PG8_SB(1, 1), b3 + hstep, voffB);
            PG8_WAIT_V(6); PG8_BAR; PG8_MMA(1, 1, At, B1); PG8_BAR;
            }
        }
        if constexpr (ALIGN_EPI) { if (wr == 0) PG8_BAR; }
        if constexpr (!Epi::AFTER_DRAIN) { E(acc, cur, wr, wc, fr, fq); S.done(cur); }
        if (!has_next) break;
#pragma unroll
        for (int a = 0; a < 2; ++a)
#pragma unroll
            for (int b = 0; b < 2; ++b)
#pragma unroll
                for (int m = 0; m < 4; ++m)
#pragma unroll
                    for (int n = 0; n < 2; ++n) acc[a][b][m][n] = (f32x4){0.f, 0.f, 0.f, 0.f};
        cur = nxt; cA = nA; cB = nB; ++ui;
        if constexpr (ALIGN_EPI) { if (wr == 1) PG8_BAR; }
    }
    PG8_WAIT_V(0);
    if constexpr (!ALIGN_EPI) { if (wr == 0) PG8_BAR; }
    PG8_BAR;
    if constexpr (Epi::AFTER_DRAIN) { E.fused(acc, cur, wr, wc, fr, fq, lds, wid, lane); S.done(cur); }
#undef PG8_SA
#undef PG8_SB
#undef PG8_STAGE
#undef PG8_LDA
#undef PG8_LDB
#undef PG8_MMA
#undef PG8_WAIT_V
#undef PG8_WAIT_L
#undef PG8_BAR
#undef PG8_SCHED
}
}

namespace att {
using bf16 = __hip_bfloat16;
constexpr int D = 128, NW = 8, QBLK = 32, KVBLK = 64;
constexpr float SCALE = 0.088388347648318440f;
constexpr float THR = 8.f;
constexpr int LDQ = 2048, LDK = 512, LDO = 2048;
constexpr size_t SHM_V = KVBLK * D * 2, SHM_K = KVBLK * D * 2, SHM_ATTN = 2 * SHM_V + 2 * SHM_K + NW * 64 * 4;
using bf16x8 = __attribute__((ext_vector_type(8))) short;
using s16x4  = __attribute__((ext_vector_type(4))) short;
using f32x16 = __attribute__((ext_vector_type(16))) float;
using u32x4  = __attribute__((ext_vector_type(4))) unsigned;
#define KSWZ(row, colB) ((row) * 256 + ((colB) ^ (((row) & 7) << 4)))
#define SBAR() __builtin_amdgcn_sched_barrier(0)
__device__ __forceinline__ int crow(int r, int hi) { return (r & 3) + 8 * (r >> 2) + 4 * hi; }
__device__ __forceinline__ unsigned cvtpk(float lo, float hi) { unsigned r; asm volatile("v_cvt_pk_bf16_f32 %0, %1, %2" : "=v"(r) : "v"(lo), "v"(hi)); return r; }
__device__ __forceinline__ void partialSM(f32x16& p0, f32x16& p1, float& m_reg, float& mn, float& alpha) {
  constexpr float C = SCALE * 1.4426950408889634f;
  float pmax = p0[0]; for (int r = 1; r < 16; ++r) pmax = fmaxf(pmax, p0[r]); for (int r = 0; r < 16; ++r) pmax = fmaxf(pmax, p1[r]);
  { auto rr = __builtin_amdgcn_permlane32_swap(__float_as_uint(pmax), __float_as_uint(pmax), false, false);
    pmax = fmaxf(__uint_as_float(rr[0]), __uint_as_float(rr[1])); }
  if (__builtin_expect(__all(pmax - m_reg <= THR / SCALE), 1)) { mn = m_reg; alpha = 1.f; }
  else { mn = fmaxf(m_reg, pmax); alpha = __builtin_amdgcn_exp2f((m_reg - mn) * C); m_reg = mn; }
  float mnC = -mn * C;
  for (int r = 0; r < 16; ++r) p0[r] = fmaf(p0[r], C, mnC); for (int r = 0; r < 16; ++r) p1[r] = fmaf(p1[r], C, mnC);
  for (int r = 0; r < 16; ++r) p0[r] = __builtin_amdgcn_exp2f(p0[r]);
}
__device__ __forceinline__ void finishSM(f32x16& p0, f32x16& p1, float alpha, float& l_reg, bf16x8& pa0, bf16x8& pa1, bf16x8& pa2, bf16x8& pa3) {
  for (int r = 0; r < 16; ++r) p1[r] = __builtin_amdgcn_exp2f(p1[r]);
  float ps = 0; for (int r = 0; r < 16; ++r) ps += p0[r]; for (int r = 0; r < 16; ++r) ps += p1[r];
  { auto rr = __builtin_amdgcn_permlane32_swap(__float_as_uint(ps), __float_as_uint(ps), false, false);
    ps = __uint_as_float(rr[0]) + __uint_as_float(rr[1]); }
  l_reg = l_reg * alpha + ps;
#define PK4(P, BASE, OUT) do { unsigned a0 = cvtpk(P[BASE + 0], P[BASE + 1]), a1 = cvtpk(P[BASE + 2], P[BASE + 3]);   \
    unsigned b0 = cvtpk(P[BASE + 4], P[BASE + 5]), b1 = cvtpk(P[BASE + 6], P[BASE + 7]);                              \
    auto r0 = __builtin_amdgcn_permlane32_swap(a0, b0, false, false); auto r1 = __builtin_amdgcn_permlane32_swap(a1, b1, false, false); \
    u32x4 w = {r0[0], r1[0], r0[1], r1[1]}; OUT = *reinterpret_cast<bf16x8*>(&w); } while (0)
  PK4(p0, 0, pa0); PK4(p0, 8, pa1); PK4(p1, 0, pa2); PK4(p1, 8, pa3);
#undef PK4
}
__device__ __forceinline__ void qkt(f32x16& p0, f32x16& p1, const bf16* Ks, const bf16x8* qr, int r32, int hi) {
  p0 = f32x16{}; p1 = f32x16{};
  for (int d0 = 0; d0 < 8; ++d0) { int cb = (d0 * 16 + hi * 8) * 2;
    bf16x8 b0 = *reinterpret_cast<const bf16x8*>((const char*)Ks + KSWZ(r32, cb));
    bf16x8 b1 = *reinterpret_cast<const bf16x8*>((const char*)Ks + KSWZ(32 + r32, cb));
    p0 = __builtin_amdgcn_mfma_f32_32x32x16_bf16(b0, qr[d0], p0, 0, 0, 0);
    p1 = __builtin_amdgcn_mfma_f32_32x32x16_bf16(b1, qr[d0], p1, 0, 0, 0); }
}
__device__ __forceinline__ int v_st(int k, int c) { const int kk = (k & ~0xC) | ((k & 4) << 1) | ((k & 8) >> 1); return ((kk >> 3) * 4 + (c >> 5)) * 512 + ((kk & 7) * 32 + (c & 31)) * 2; }
__device__ __forceinline__ int v_rd_base(int lane) { return ((lane & 3) << 3) | (((lane >> 2) & 3) << 6) | (((lane >> 4) & 1) << 5) | (((lane >> 5) & 1) << 8); }
constexpr int v_rd_off(int d0, int ks, int half) { return d0 * 512 + ks * 4096 + half * 2048; }
template <int OFF> __device__ __forceinline__ s16x4 tr_read(int vb) {
  s16x4 r; asm volatile("ds_read_b64_tr_b16 %0, %1 offset:%2" : "=&v"(r) : "v"(vb), "i"(OFF) : "memory"); return r;
}
template <int D0> __device__ __forceinline__ void pv_one(f32x16& od, int vb, bf16x8 pa0, bf16x8 pa1, bf16x8 pa2, bf16x8 pa3) {
  const s16x4 l0 = tr_read<v_rd_off(D0, 0, 0)>(vb), h0 = tr_read<v_rd_off(D0, 0, 1)>(vb), l1 = tr_read<v_rd_off(D0, 1, 0)>(vb), h1 = tr_read<v_rd_off(D0, 1, 1)>(vb);
  const s16x4 l2 = tr_read<v_rd_off(D0, 2, 0)>(vb), h2 = tr_read<v_rd_off(D0, 2, 1)>(vb), l3 = tr_read<v_rd_off(D0, 3, 0)>(vb), h3 = tr_read<v_rd_off(D0, 3, 1)>(vb);
  asm volatile("s_waitcnt lgkmcnt(0)" ::: "memory"); SBAR();
#define PK(L, H) (bf16x8){L[0], L[1], L[2], L[3], H[0], H[1], H[2], H[3]}
  od = __builtin_amdgcn_mfma_f32_32x32x16_bf16(pa0, PK(l0, h0), od, 0, 0, 0);
  od = __builtin_amdgcn_mfma_f32_32x32x16_bf16(pa1, PK(l1, h1), od, 0, 0, 0);
  od = __builtin_amdgcn_mfma_f32_32x32x16_bf16(pa2, PK(l2, h2), od, 0, 0, 0);
  od = __builtin_amdgcn_mfma_f32_32x32x16_bf16(pa3, PK(l3, h3), od, 0, 0, 0);
#undef PK
}
__device__ __forceinline__ void pv_d0(f32x16* o, int vb, bf16x8 pa0, bf16x8 pa1, bf16x8 pa2, bf16x8 pa3) {
  pv_one<0>(o[0], vb, pa0, pa1, pa2, pa3); pv_one<1>(o[1], vb, pa0, pa1, pa2, pa3); pv_one<2>(o[2], vb, pa0, pa1, pa2, pa3); pv_one<3>(o[3], vb, pa0, pa1, pa2, pa3);
}
__device__ __forceinline__ void attn_dense_body(const bf16* __restrict__ Qb, const bf16* __restrict__ Kh, const bf16* __restrict__ Vh,
                                                bf16* __restrict__ Ob, int seq, char* lds, const int tid) {
  const int wid = tid >> 6, lane = tid & 63, r32 = lane & 31, hi = lane >> 5;
  bf16* V_lds = (bf16*)lds; bf16* K_lds = (bf16*)(lds + 2 * SHM_V);
  float* ws = (float*)(lds + 2 * SHM_V + 2 * SHM_K) + wid * 64; float* li_l = ws; float* al_l = ws + 32;
  float m_reg = -1e30f, l_reg = 0; f32x16 o[4] = {}; bf16x8 qr[8];
  const bf16* Qw = Qb + (long)(wid * QBLK + r32) * LDQ + hi * 8;
#pragma unroll
  for (int d0 = 0; d0 < 8; ++d0) qr[d0] = *reinterpret_cast<const bf16x8*>(Qw + d0 * 16);
  const int sr = tid >> 4, sc = (tid & 15) * 8, vst0 = v_st(sr, sc), vst1 = v_st(32 + sr, sc);
  const int vb0 = (int)(uintptr_t)V_lds + v_rd_base(lane);
  struct { bf16x8 vs0, vs1, ks0, ks1; } sr_[2];
#define SLOAD(i, k0) do { sr_[i].vs0 = *reinterpret_cast<const bf16x8*>(&Vh[(long)((k0) + sr) * LDK + sc]); sr_[i].vs1 = *reinterpret_cast<const bf16x8*>(&Vh[(long)((k0) + 32 + sr) * LDK + sc]); \
    sr_[i].ks0 = *reinterpret_cast<const bf16x8*>(&Kh[(long)((k0) + sr) * LDK + sc]); sr_[i].ks1 = *reinterpret_cast<const bf16x8*>(&Kh[(long)((k0) + 32 + sr) * LDK + sc]); } while (0)
#define SWRITE(b, i) do { *(bf16x8*)((char*)V_lds + (b) * SHM_V + vst0) = sr_[i].vs0;          \
    *(bf16x8*)((char*)V_lds + (b) * SHM_V + vst1) = sr_[i].vs1; int kc = sc * 2;               \
    *(bf16x8*)((char*)K_lds + (b) * SHM_K + KSWZ(sr, kc)) = sr_[i].ks0;                       \
    *(bf16x8*)((char*)K_lds + (b) * SHM_K + KSWZ(32 + sr, kc)) = sr_[i].ks1; } while (0)
#define SWAIT() do { asm volatile("s_waitcnt vmcnt(4)" ::: "memory"); } while (0)
#define RESC(a) do { if (__any((a) < 1.f)) { if (hi == 0) al_l[r32] = (a); asm volatile("s_waitcnt lgkmcnt(0)" ::: "memory"); \
    for (int d = 0; d < 4; ++d) for (int r = 0; r < 16; ++r) o[d][r] *= al_l[crow(r, hi)]; } } while (0)
  f32x16 pA0, pA1, pB0, pB1; float mnA, mnB, alA, alB; bf16x8 pa0, pa1, pa2, pa3; const int NT = seq / KVBLK;
  constexpr int SE = 0, SO = 1;
  SLOAD(SE, 0); asm volatile("s_waitcnt vmcnt(0)" ::: "memory"); SWRITE(0, SE); __syncthreads();
  qkt(pA0, pA1, K_lds, qr, r32, hi); partialSM(pA0, pA1, m_reg, mnA, alA);
  SLOAD(SO, KVBLK); { if (2 < NT) SLOAD(SE, 2 * KVBLK); }
  SWAIT(); SWRITE(1, SO); __syncthreads();
  for (int j = 1; j + 1 < NT; j += 2) {
    SBAR(); qkt(pB0, pB1, (bf16*)((char*)K_lds + SHM_K), qr, r32, hi);
    finishSM(pA0, pA1, alA, l_reg, pa0, pa1, pa2, pa3); SBAR();
    SLOAD(SO, (j + 2) * KVBLK); SBAR();
    pv_d0(o, vb0, pa0, pa1, pa2, pa3); partialSM(pB0, pB1, m_reg, mnB, alB);
    __syncthreads(); SWAIT(); SWRITE(0, SE);
    RESC(alB); __syncthreads();
    SBAR(); qkt(pA0, pA1, K_lds, qr, r32, hi);
    finishSM(pB0, pB1, alB, l_reg, pa0, pa1, pa2, pa3); SBAR();
    if (j + 3 < NT) SLOAD(SE, (j + 3) * KVBLK); SBAR();
    pv_d0(o, vb0 + (int)SHM_V, pa0, pa1, pa2, pa3); partialSM(pA0, pA1, m_reg, mnA, alA);
    __syncthreads(); SWAIT(); SWRITE(1, SO);
    RESC(alA); __syncthreads();
  }
  SBAR(); qkt(pB0, pB1, (bf16*)((char*)K_lds + SHM_K), qr, r32, hi);
  finishSM(pA0, pA1, alA, l_reg, pa0, pa1, pa2, pa3); SBAR();
  pv_d0(o, vb0, pa0, pa1, pa2, pa3); partialSM(pB0, pB1, m_reg, mnB, alB);
  __syncthreads(); RESC(alB);
  finishSM(pB0, pB1, alB, l_reg, pa0, pa1, pa2, pa3); SBAR();
  pv_d0(o, vb0 + (int)SHM_V, pa0, pa1, pa2, pa3);
  if (hi == 0) li_l[r32] = l_reg; asm volatile("s_waitcnt lgkmcnt(0)" ::: "memory");
  float rli[16];
#pragma unroll
  for (int r = 0; r < 16; ++r) rli[r] = __builtin_amdgcn_rcpf(li_l[crow(r, hi)]);
  bf16* Ow = Ob + (long)(wid * QBLK) * LDO;
#pragma unroll
  for (int r = 0; r < 16; ++r) { int orow = crow(r, hi);
    for (int d0 = 0; d0 < 4; ++d0) Ow[(long)orow * LDO + d0 * 32 + r32] = __float2bfloat16(o[d0][r] * rli[r]); }
#undef SLOAD
#undef SWRITE
#undef SWAIT
#undef RESC
}
}

typedef unsigned short bf16_t;
typedef short bf16x8 __attribute__((ext_vector_type(8)));
typedef short s16x4 __attribute__((ext_vector_type(4)));
typedef float f32x4 __attribute__((ext_vector_type(4)));
typedef unsigned u32x4 __attribute__((ext_vector_type(4)));
typedef unsigned u32x2 __attribute__((ext_vector_type(2)));
#define LAS __attribute__((address_space(3)))

constexpr int DM = 2048, NBATCH = 4, SEQ = 2048, CTXL = 256, ML = NBATCH * SEQ, MC = NBATCH * CTXL, MT = ML + MC;
constexpr int FF = 5632, FF2 = 2 * FF, NRIN = 6 * DM, NAIN = 3072, SKV = CTXL + SEQ;
constexpr int NWAVES = 8, NTHR = 512;
constexpr int LDS_BYTES = 144 * 1024, BAR_LDS_OFF = 140 * 1024;
constexpr float EPS = 1e-6f;

constexpr size_t al256(size_t x) { return (x + 255) / 256 * 256; }
constexpr size_t WS_CTL   = 0;
constexpr size_t WS_MOD   = 16384;
constexpr size_t WS_ROPER = WS_MOD + al256((size_t)2 * 5 * 12288 * 4);
constexpr size_t WS_ROPEA = WS_ROPER + (size_t)2 * 2048 * 128 * 4;
constexpr size_t WS_WRIN  = WS_ROPEA + (size_t)2 * 2048 * 64 * 4;
constexpr size_t WS_WROUT = WS_WRIN + (size_t)NRIN * DM * 2;
constexpr size_t WS_WAIN  = WS_WROUT + (size_t)DM * 2 * DM * 2;
constexpr size_t WS_WAOUT = WS_WAIN + (size_t)NAIN * DM * 2;
constexpr size_t WS_WUP   = WS_WAOUT + (size_t)DM * DM * 2;
constexpr size_t WS_WDN   = WS_WUP + (size_t)2 * FF2 * DM * 2;
constexpr size_t WS_XS    = WS_WDN + (size_t)2 * DM * FF * 2;
constexpr size_t WS_H     = WS_XS + (size_t)MT * DM * 4;
constexpr size_t WS_R1    = WS_H + (size_t)MT * DM * 2;
constexpr size_t R1_Q = 0, R1_K = (size_t)MT * DM * 2, R1_V = 2 * R1_K, R1_G = R1_V + (size_t)MT * 4096 * 2, R1_BYTES = R1_G + (size_t)MT * 4096 * 2;
constexpr size_t R1_QN = 0, R1_KN = (size_t)ML * DM * 2, R1_VN = R1_KN + (size_t)NBATCH * SKV * 512 * 2, R1_O = R1_VN + (size_t)NBATCH * SKV * 512 * 2;
constexpr size_t R1_HP = 0, R1_HU = (size_t)16 << 20;
constexpr size_t WS_R2    = WS_R1 + R1_BYTES;
constexpr size_t R2_BYTES = (size_t)2 * MT * 4096 * 2;
constexpr size_t WS_END   = WS_R2 + R2_BYTES;
static_assert((size_t)MT * FF2 * 2 <= R1_BYTES, "U fits region 1");
static_assert(R1_O + (size_t)ML * DM * 2 <= R1_BYTES, "layer-1 attention tensors fit region 1");

struct Args { const float* in[20]; float* out; unsigned char* ws; int ph_lo, ph_hi; };
enum { I_X = 0, I_C, I_CTX, I_CCTX, I_ADAW, I_ADAB, I_NORMW, I_RWIN, I_RWOUT, I_RLD, I_RGN, I_AWIN, I_AWOUT, I_AQN, I_AKN, I_FUP, I_FCW, I_FCB, I_FDN, I_FNW };
constexpr int NPH = 20;
#ifndef ONLY_PHASE
#define PHSEL(p) (p)
#else
#define PHSEL(p) ((p) == ONLY_PHASE ? ONLY_PHASE : -1)
#endif

__device__ __forceinline__ float wave_sum(float v) {
#pragma unroll
    for (int o = 1; o < 64; o <<= 1) v += __shfl_xor(v, o);
    return v;
}
__device__ __forceinline__ unsigned pk2(float lo, float hi) { unsigned r; asm volatile("v_cvt_pk_bf16_f32 %0, %1, %2" : "=v"(r) : "v"(lo), "v"(hi)); return r; }
__device__ __forceinline__ float bf2f(unsigned short h) { return __uint_as_float((unsigned)h << 16); }
__device__ __forceinline__ float silu_f(float x) { return x / (1.f + __expf(-x)); }
__device__ __forceinline__ void unpack8(const bf16x8 v, float* f) {
#pragma unroll
    for (int i = 0; i < 8; ++i) f[i] = bf2f((unsigned short)v[i]);
}
__device__ __forceinline__ u32x4 pack8f(const float* f) { u32x4 w; w.x = pk2(f[0], f[1]); w.y = pk2(f[2], f[3]); w.z = pk2(f[4], f[5]); w.w = pk2(f[6], f[7]); return w; }

constexpr int TR_SCR = 64 * 65 * 4;
template <bool PAIR = false>
__device__ __forceinline__ void transpose_item(const float* __restrict__ W, int K, int N, bf16_t* __restrict__ WT, LAS float* scr, int item, int lane) {
    const int nblk = N / 64, kb = item / nblk, nb = item % nblk, k0 = 64 * kb, n0 = 64 * nb;
    const int lr = lane >> 4, lc = (lane & 15) * 4;
#pragma unroll 8
    for (int i = 0; i < 16; ++i) { const int kk = 4 * i + lr; const f32x4 v = *(const f32x4*)(W + (size_t)(k0 + kk) * N + n0 + lc);
        LAS float* d = scr + kk * 65 + lc; d[0] = v[0]; d[1] = v[1]; d[2] = v[2]; d[3] = v[3]; }
    asm volatile("s_waitcnt lgkmcnt(0)" ::: "memory");
    const int c = lane & 7;
#pragma unroll
    for (int j = 0; j < 8; ++j) { const int n = (lane >> 3) + 8 * j; const LAS float* sp = scr + (8 * c) * 65 + n;
        u32x4 o; o.x = pk2(sp[0 * 65], sp[1 * 65]); o.y = pk2(sp[2 * 65], sp[3 * 65]); o.z = pk2(sp[4 * 65], sp[5 * 65]); o.w = pk2(sp[6 * 65], sp[7 * 65]);
        const int col = n0 + n, half = N / 2, cc = col < half ? col : col - half; const int orow = PAIR ? ((cc >> 7) * 256 + (col < half ? 0 : 128) + (cc & 127)) : col;
        *(u32x4*)(WT + (size_t)orow * K + k0 + 8 * c) = o; }
    asm volatile("s_waitcnt lgkmcnt(0)" ::: "memory");
}
__device__ __forceinline__ void convert_jobs(int list, const Args& a, unsigned char* ws, LAS unsigned char* lds, int widx, int nw, int wave, int lane) {
    if (widx < 0) return;
    LAS float* scr = (LAS float*)(lds + wave * TR_SCR);
    const int gw = widx * NWAVES + wave, NGW = nw * NWAVES;
    constexpr int I_RIN = (DM / 64) * (NRIN / 64), I_ROUT = (2 * DM / 64) * (DM / 64), I_AIN = (DM / 64) * (NAIN / 64), I_AOUT = (DM / 64) * (DM / 64), I_UP = (DM / 64) * (FF2 / 64), I_DN = (FF / 64) * (DM / 64);
    if (list == 0) {
        for (int it = gw; it < I_RIN + I_UP + I_DN; it += NGW) { int r = it;
            if (r < I_RIN) { transpose_item(a.in[I_RWIN], DM, NRIN, (bf16_t*)(ws + WS_WRIN), scr, r, lane); continue; } r -= I_RIN;
            if (r < I_UP) { transpose_item<true>(a.in[I_FUP], DM, FF2, (bf16_t*)(ws + WS_WUP), scr, r, lane); continue; } r -= I_UP;
            transpose_item(a.in[I_FDN], FF, DM, (bf16_t*)(ws + WS_WDN), scr, r, lane); }
    } else if (list == 1) {
        for (int it = gw; it < I_ROUT; it += NGW) transpose_item(a.in[I_RWOUT], 2 * DM, DM, (bf16_t*)(ws + WS_WROUT), scr, it, lane);
    } else {
        for (int it = gw; it < I_AIN + I_AOUT + I_UP + I_DN; it += NGW) { int r = it;
            if (r < I_AIN) { transpose_item(a.in[I_AWIN], DM, NAIN, (bf16_t*)(ws + WS_WAIN), scr, r, lane); continue; } r -= I_AIN;
            if (r < I_AOUT) { transpose_item(a.in[I_AWOUT], DM, DM, (bf16_t*)(ws + WS_WAOUT), scr, r, lane); continue; } r -= I_AOUT;
            if (r < I_UP) { transpose_item<true>(a.in[I_FUP] + (size_t)DM * FF2, DM, FF2, (bf16_t*)(ws + WS_WUP) + (size_t)FF2 * DM, scr, r, lane); continue; } r -= I_UP;
            transpose_item(a.in[I_FDN] + (size_t)FF * DM, FF, DM, (bf16_t*)(ws + WS_WDN) + (size_t)DM * FF, scr, r, lane); }
    }
}
__device__ __forceinline__ void phase_prologue(const Args& a, unsigned char* ws, LAS unsigned char* lds, int bid, int G, int tid, int wave, int lane) {
    convert_jobs(0, a, ws, lds, bid, G, wave, lane);
    __syncthreads();
    {
        LAS float* act = (LAS float*)lds;
        LAS float* red = (LAS float*)(lds + 40960);
        for (int i = tid; i < 5 * DM; i += NTHR) { const int r = i / DM, k = i % DM; const float v = r < 4 ? a.in[I_C][r * DM + k] : a.in[I_CCTX][k]; act[i] = silu_f(v); }
        __syncthreads();
        const int c4 = tid & 15, ks = tid >> 4;
        for (int it = bid; it < 2 * 192 * 2; it += G) {
            const int kh = it & 1, l = (it >> 1) / 192, c0 = ((it >> 1) % 192) * 64, kbase = kh * 1024 + ks * 32;
            f32x4 acc[5];
#pragma unroll
            for (int r = 0; r < 5; ++r) acc[r] = (f32x4){0.f, 0.f, 0.f, 0.f};
            const float* wp = a.in[I_ADAW] + (size_t)l * DM * 12288 + (size_t)kbase * 12288 + c0 + c4 * 4;
#pragma unroll 8
            for (int kk = 0; kk < 32; ++kk) { const f32x4 w = *(const f32x4*)(wp + (size_t)kk * 12288);
#pragma unroll
                for (int r = 0; r < 5; ++r) acc[r] += act[r * DM + kbase + kk] * w; }
#pragma unroll
            for (int r = 0; r < 5; ++r) *(LAS f32x4*)(red + (ks * 5 + r) * 64 + c4 * 4) = acc[r];
            __syncthreads();
            if (tid < 320) { const int r = tid >> 6, c = tid & 63; float sm = 0.f;
                for (int k2 = 0; k2 < 32; ++k2) sm += red[(k2 * 5 + r) * 64 + c];
                if (kh == 0) sm += a.in[I_ADAB][l * 12288 + c0 + c];
                atomicAdd((float*)(ws + WS_MOD) + (size_t)(l * 5 + r) * 12288 + c0 + c, sm); }
            __syncthreads();
        }
    }
    {
        float* cr = (float*)(ws + WS_ROPER); float* sr = cr + 2048 * 128; float* ca = (float*)(ws + WS_ROPEA); float* sa = ca + 2048 * 64;
        const int gt = bid * NTHR + tid, NT = G * NTHR;
        for (int idx = gt; idx < 2048 * 128; idx += NT) { const int t = idx >> 7, i = idx & 127, f = i & 63; const int pos = (i < 64) ? (t >> 6) : (t & 63);
            const float inv = powf(10000.f, -(float)f / 64.f), ang = (float)pos * inv; float s, c; sincosf(ang, &s, &c); cr[idx] = c; sr[idx] = s; }
        for (int idx = gt; idx < 2048 * 64; idx += NT) { const int t = idx >> 6, i = idx & 63, f = i & 31; const int pos = (i < 32) ? (t >> 6) : (t & 63);
            const float inv = powf(10000.f, -(float)f / 32.f), ang = (float)pos * inv; float s, c; sincosf(ang, &s, &c); ca[idx] = c; sa[idx] = s; }
    }
}

__device__ __forceinline__ void phase_norm(const float* srcX, const float* srcC, const float* nw, const float* mod  , int shoff, bf16_t* H, int nrows,
                                           const float* slab, float* XS, int bid, int G, int wave, int lane) {
    const int gw = bid * NWAVES + wave, NGW = G * NWAVES;
    const int WC = slab ? 9 : 1, nlat = nrows < ML ? nrows : ML, vtot = nlat + (nrows - nlat) * WC;
    const int v_lo = (int)((long)gw * vtot / NGW), v_hi = (int)((long)(gw + 1) * vtot / NGW);
    const int r_lo = v_lo <= nlat ? v_lo : nlat + (v_lo - nlat + WC - 1) / WC, r_hi = v_hi <= nlat ? v_hi : nlat + (v_hi - nlat + WC - 1) / WC;
    f32x4 A[8], B[8]; int cur_mr = -1;
    for (int row = r_lo; row < r_hi; ++row) {
        const float* src = row < ML ? srcX + (size_t)row * DM : srcC + (size_t)(row - ML) * DM;
        const int mr = row < ML ? (row >> 11) : 4;
        f32x4 v[8]; float ss = 0.f;
#pragma unroll
        for (int j = 0; j < 8; ++j) v[j] = *(const f32x4*)(src + (lane + 64 * j) * 4);
        if (slab && row >= ML) {
            const float* sp = slab + ((size_t)((row - ML) >> 8) * 64 * 256 + (row & 255)) * 256;
#pragma unroll
            for (int j = 0; j < 8; ++j) { const int c = (lane + 64 * j) * 4; const float* sq = sp + (size_t)(c >> 8) * 8 * 65536 + (c & 255);
#pragma unroll
                for (int sl = 0; sl < 8; ++sl) v[j] += *(const f32x4*)(sq + (size_t)sl * 65536);
                *(f32x4*)(XS + (size_t)row * DM + c) = v[j]; }
        }
#pragma unroll
        for (int j = 0; j < 8; ++j) ss += (v[j][0] * v[j][0] + v[j][1] * v[j][1]) + (v[j][2] * v[j][2] + v[j][3] * v[j][3]);
        if (mr != cur_mr) { cur_mr = mr; const float* sh = mod + mr * 12288 + shoff; const float* sc = sh + DM;
#pragma unroll
            for (int j = 0; j < 8; ++j) { const int c = (lane + 64 * j) * 4; A[j] = *(const f32x4*)(nw + c) * (1.f + *(const f32x4*)(sc + c)); B[j] = *(const f32x4*)(sh + c); } }
        const float rstd = 1.0f / sqrtf(wave_sum(ss) * (1.f / DM) + EPS);
#pragma unroll
        for (int j = 0; j < 8; ++j) { const int c = (lane + 64 * j) * 4; const f32x4 h = (v[j] * rstd) * A[j] + B[j];
            u32x2 o; o.x = pk2(h[0], h[1]); o.y = pk2(h[2], h[3]); *(u32x2*)(H + (size_t)row * DM + c) = o; }
    }
}
__device__ __forceinline__ void phase_final(const float* XS, const float* nw, float* out, int bid, int G, int wave, int lane) {
    const int gw = bid * NWAVES + wave, NGW = G * NWAVES;
    for (int row = gw; row < ML; row += NGW) {
        const float* src = XS + (size_t)row * DM;
        f32x4 v[8]; float ss = 0.f;
#pragma unroll
        for (int j = 0; j < 8; ++j) { v[j] = *(const f32x4*)(src + (lane + 64 * j) * 4); ss += (v[j][0] * v[j][0] + v[j][1] * v[j][1]) + (v[j][2] * v[j][2] + v[j][3] * v[j][3]); }
        const float rstd = 1.0f / sqrtf(wave_sum(ss) * (1.f / DM) + EPS);
#pragma unroll
        for (int j = 0; j < 8; ++j) { const int c = (lane + 64 * j) * 4; const f32x4 w = *(const f32x4*)(nw + c); *(f32x4*)(out + (size_t)row * DM + c) = (v[j] * rstd) * w; }
    }
}

constexpr int RP = 136;
constexpr int RT_BYTES = 128 * RP * 2;
__device__ __forceinline__ bf16x8 ret_trfrag(const LAS bf16_t* T, int k0, int c0, int lane) {
    const int i = lane & 15, g = lane >> 4, q = i >> 2, p = i & 3;
    const LAS bf16_t* a1 = T + (k0 + 8 * g + q) * RP + c0 + 4 * p;
    const s16x4 lo = __builtin_amdgcn_ds_read_tr16_b64_v4i16((LAS s16x4*)a1);
    const s16x4 hi = __builtin_amdgcn_ds_read_tr16_b64_v4i16((LAS s16x4*)(a1 + 4 * RP));
    return (bf16x8){lo[0], lo[1], lo[2], lo[3], hi[0], hi[1], hi[2], hi[3]};
}
typedef int i32x4 __attribute__((ext_vector_type(4)));
__device__ __forceinline__ void ret_gload(bf16x8 (&r)[4], const bf16_t* src  , int ld, int tid) {
    const auto rs = __builtin_amdgcn_make_buffer_rsrc((void*)src, 0, 0x7fffffff, 0x00020000);
    const unsigned off0 = ((unsigned)(tid >> 4) * (unsigned)ld + (unsigned)(tid & 15) * 8u) * 2u;
#pragma unroll
    for (int i = 0; i < 4; ++i) r[i] = __builtin_bit_cast(bf16x8, __builtin_amdgcn_raw_buffer_load_b128(rs, off0, i * 32 * ld * 2, 0));
}
__device__ __forceinline__ void ret_lwrite(LAS bf16_t* dst, const bf16x8 (&r)[4], int tid) {
#pragma unroll
    for (int i = 0; i < 4; ++i) { const int id = tid + NTHR * i, row = id >> 4, cc = id & 15; *(LAS bf16x8*)(dst + row * RP + cc * 8) = r[i]; }
}
__device__ __forceinline__ int ret_row0(int s, int dir, int b) {
    const bool isctx = s < 2; const int ci = dir == 0 ? (isctx ? s : s - 2) : (isctx ? 1 - s : 17 - s);
    return isctx ? ML + b * CTXL + ci * 128 : b * SEQ + ci * 128;
}
#define RET_SCORES() do { \
    _Pragma("unroll") for (int ks = 0; ks < 4; ++ks) { bf16x8 qf[2], kf[4]; \
        _Pragma("unroll") for (int a_ = 0; a_ < 2; ++a_) qf[a_] = *(const LAS bf16x8*)(QH + (16 * (qt0 + a_) + fr) * RP + ks * 32 + 8 * g); \
        _Pragma("unroll") for (int c_ = 0; c_ < 4; ++c_) kf[c_] = *(const LAS bf16x8*)(KH + (16 * (kt0 + c_) + fr) * RP + ks * 32 + 8 * g); \
        _Pragma("unroll") for (int a_ = 0; a_ < 2; ++a_) _Pragma("unroll") for (int c_ = 0; c_ < 4; ++c_) sc[a_][c_] = __builtin_amdgcn_mfma_f32_16x16x32_bf16(kf[c_], qf[a_], sc[a_][c_], 0, 0, 0); \
        __builtin_amdgcn_sched_barrier(0); } } while (0)
#define RET_INTER_UPDATE(HH) do { \
    _Pragma("unroll") for (int p = 0; p < 4; ++p) { \
        const f32x4 sa = S[8 * (HH) + 2 * p], sb = S[8 * (HH) + 2 * p + 1]; \
        u32x4 bw; bw.x = pk2(sa[0], sa[1]); bw.y = pk2(sa[2], sa[3]); bw.z = pk2(sb[0], sb[1]); bw.w = pk2(sb[2], sb[3]); \
        const bf16x8 sfrag = __builtin_bit_cast(bf16x8, bw); \
        _Pragma("unroll") for (int nt = 0; nt < 8; ++nt) { \
            const LAS bf16_t* qa = QH + (16 * nt + fr) * RP + 32 * p + 4 * g; \
            const s16x4 lo = *(const LAS s16x4*)qa, hi = *(const LAS s16x4*)(qa + 16); \
            const bf16x8 qfrag = (bf16x8){lo[0], lo[1], lo[2], lo[3], hi[0], hi[1], hi[2], hi[3]}; \
            oi[nt] = __builtin_amdgcn_mfma_f32_16x16x32_bf16(sfrag, qfrag, oi[nt], 0, 0, 0); \
            if (nt == 3) __builtin_amdgcn_sched_barrier(0); } \
        __builtin_amdgcn_sched_barrier(0); } \
    { const float cd = __builtin_amdgcn_exp2f(lg2 * 128.f); \
      _Pragma("unroll") for (int j = 0; j < 8; ++j) S[8 * (HH) + j] = S[8 * (HH) + j] * cd; } \
    _Pragma("unroll") for (int ks = 0; ks < 4; ++ks) { \
        bf16x8 vf = ret_trfrag(VV, 32 * ks, ew, lane_o); \
        { float f[8]; unpack8(vf, f); \
          _Pragma("unroll") for (int jj = 0; jj < 8; ++jj) { const int m = 32 * ks + 8 * g + jj; f[jj] *= __builtin_amdgcn_exp2f(lg2 * (float)(dir == 0 ? 127 - m : m)); } \
          vf = __builtin_bit_cast(bf16x8, pack8f(f)); } \
        _Pragma("unroll") for (int j = 0; j < 8; ++j) { const bf16x8 kT = ret_trfrag(KH, 32 * ks, 16 * j, lane_o); \
            S[8 * (HH) + j] = __builtin_amdgcn_mfma_f32_16x16x32_bf16(kT, vf, S[8 * (HH) + j], 0, 0, 0); \
            if (j == 3) __builtin_amdgcn_sched_barrier(0); } \
        __builtin_amdgcn_sched_barrier(0); } } while (0)
__device__ __forceinline__ void phase_retention(const bf16_t* Qb, const bf16_t* Kb, const bf16_t* Vb, bf16_t* OD, const float* logdecay, LAS unsigned char* lds, int bid, int G, int tid, int wave, int lane) {
    LAS bf16_t* QH = (LAS bf16_t*)lds; LAS bf16_t* KH = (LAS bf16_t*)(lds + RT_BYTES); LAS bf16_t* VV = (LAS bf16_t*)(lds + 2 * RT_BYTES); LAS bf16_t* PP = (LAS bf16_t*)(lds + 3 * RT_BYTES);
    const int ew = 16 * wave;
    const int qt0 = 2 * (wave >> 1), kt0 = 4 * (wave & 1);
    for (int u = bid; u < 256; u += G) {
        const int es = u & 3, dir = (u >> 2) & 1, h = (u >> 3) & 7, b = u >> 6, e0 = es * 128;
        const float lg2u = -expf(logdecay[dir * 8 + h]) * 1.4426950408889634f;
        f32x4 S[16];
#pragma unroll
        for (int i = 0; i < 16; ++i) S[i] = (f32x4){0.f, 0.f, 0.f, 0.f};
        bf16x8 RQ[4], RK[4], RV[4];
        { const int r0 = ret_row0(0, dir, b);
          ret_gload(RV, Vb + (size_t)r0 * 4096 + h * 512 + e0, 4096, tid); ret_gload(RQ, Qb + (size_t)r0 * 2048 + h * 256, 2048, tid); ret_gload(RK, Kb + (size_t)r0 * 2048 + h * 256, 2048, tid); }
        for (int s = 0; s < 18; ++s) {
            int tid_o = tid; asm volatile("" : "+v"(tid_o)); const int lane_o = tid_o & 63, fr = lane_o & 15, g = lane_o >> 4;
            float lg2 = lg2u; asm volatile("" : "+v"(lg2));
            const int row0 = ret_row0(s, dir, b);
            const bf16_t* qp = Qb + (size_t)row0 * 2048 + h * 256; const bf16_t* kp = Kb + (size_t)row0 * 2048 + h * 256;
            f32x4 oi[8];
            __syncthreads();
            ret_lwrite(VV, RV, tid_o); ret_lwrite(QH, RQ, tid_o); ret_lwrite(KH, RK, tid_o);
            __syncthreads();
            ret_gload(RQ, qp + 128, 2048, tid_o); ret_gload(RK, kp + 128, 2048, tid_o);
            {
                f32x4 sc[2][4];
#pragma unroll
                for (int i = 0; i < 2; ++i)
#pragma unroll
                    for (int j = 0; j < 4; ++j) sc[i][j] = (f32x4){0.f, 0.f, 0.f, 0.f};
                RET_SCORES();
                __syncthreads();
                ret_lwrite(QH, RQ, tid_o); ret_lwrite(KH, RK, tid_o);
                __syncthreads();
                ret_gload(RQ, qp, 2048, tid_o); ret_gload(RK, kp, 2048, tid_o);
                RET_SCORES();
#pragma unroll
                for (int a = 0; a < 2; ++a)
#pragma unroll
                    for (int c = 0; c < 4; ++c) { const int n = 16 * (qt0 + a) + fr, m0 = 16 * (kt0 + c) + 4 * g; float pv[4];
#pragma unroll
                        for (int r = 0; r < 4; ++r) { const int m = m0 + r; const int dd = dir == 0 ? n - m : m - n; pv[r] = dd >= 0 ? sc[a][c][r] * __builtin_amdgcn_exp2f(lg2 * (float)dd) : 0.f; }
                        u32x2 w; w.x = pk2(pv[0], pv[1]); w.y = pk2(pv[2], pv[3]); *(LAS u32x2*)(PP + n * RP + m0) = w; }
            }
#pragma unroll
            for (int i = 0; i < 8; ++i) oi[i] = (f32x4){0.f, 0.f, 0.f, 0.f};
            RET_INTER_UPDATE(1);
            __syncthreads();
            ret_lwrite(QH, RQ, tid_o); ret_lwrite(KH, RK, tid_o);
            __syncthreads();
            if (s + 1 < 18) { const int r1 = ret_row0(s + 1, dir, b);
                ret_gload(RV, Vb + (size_t)r1 * 4096 + h * 512 + e0, 4096, tid_o); ret_gload(RQ, Qb + (size_t)r1 * 2048 + h * 256, 2048, tid_o); ret_gload(RK, Kb + (size_t)r1 * 2048 + h * 256, 2048, tid_o); }
            RET_INTER_UPDATE(0);
#pragma unroll
            for (int nt = 0; nt < 8; ++nt) { const int n = 16 * nt + fr; const float qd = __builtin_amdgcn_exp2f(lg2 * (float)(dir == 0 ? n + 1 : 128 - n)); oi[nt] = oi[nt] * qd; }
#pragma unroll
            for (int ks = 0; ks < 4; ++ks) { const bf16x8 vf = ret_trfrag(VV, 32 * ks, ew, lane_o);
#pragma unroll
                for (int nt = 0; nt < 8; ++nt) { const bf16x8 pf = *(const LAS bf16x8*)(PP + (16 * nt + fr) * RP + 32 * ks + 8 * g);
                    oi[nt] = __builtin_amdgcn_mfma_f32_16x16x32_bf16(vf, pf, oi[nt], 0, 0, 0);
                    if (nt == 3) __builtin_amdgcn_sched_barrier(0); }
                __builtin_amdgcn_sched_barrier(0); }
            bf16_t* op = OD + (size_t)dir * MT * 4096 + (size_t)row0 * 4096 + h * 512 + e0 + ew;
            const unsigned ooff = ((unsigned)fr * 4096u + 4u * (unsigned)g) * 2u;
            const auto ors = __builtin_amdgcn_make_buffer_rsrc((void*)op, 0, 0x7fffffff, 0x00020000);
#pragma unroll
            for (int nt = 0; nt < 8; ++nt) { u32x2 w; w.x = pk2(oi[nt][0], oi[nt][1]); w.y = pk2(oi[nt][2], oi[nt][3]); __builtin_amdgcn_raw_buffer_store_b64(w, ors, ooff, 16 * nt * 4096 * 2, 0); }
        }
        __syncthreads();
    }
}
#undef RET_SCORES
#undef RET_INTER_UPDATE
__device__ __forceinline__ void phase_combine(const bf16_t* OD, const bf16_t* Gb, const float* gnw, bf16_t* Y, int bid, int G, int wave, int lane) {
    const int gw = bid * NWAVES + wave, NGW = G * NWAVES;
    for (int it = gw; it < MT * 8; it += NGW) {
        const int row = it >> 3, h = it & 7; const size_t off = (size_t)row * 4096 + h * 512 + lane * 8;
        float a[8], b2[8], gg[8];
        unpack8(*(const bf16x8*)(OD + off), a); unpack8(*(const bf16x8*)(OD + (size_t)MT * 4096 + off), b2); unpack8(*(const bf16x8*)(Gb + off), gg);
        float s = 0.f;
#pragma unroll
        for (int i = 0; i < 8; ++i) { a[i] += b2[i]; s += a[i]; }
        const float mu = wave_sum(s) * (1.f / 512.f); float q = 0.f;
#pragma unroll
        for (int i = 0; i < 8; ++i) { a[i] -= mu; q += a[i] * a[i]; }
        const float rstd = 1.0f / sqrtf(wave_sum(q) * (1.f / 512.f) + EPS);
        const f32x4 w0 = *(const f32x4*)(gnw + h * 512 + lane * 8), w1 = *(const f32x4*)(gnw + h * 512 + lane * 8 + 4);
        float o[8];
#pragma unroll
        for (int i = 0; i < 8; ++i) o[i] = a[i] * rstd * (i < 4 ? w0[i] : w1[i - 4]) * silu_f(gg[i]);
        *(u32x4*)(Y + off) = pack8f(o);
    }
}
__device__ __forceinline__ void phase_conv_fix(const float* __restrict__ HP, const float* __restrict__ HU, const float* __restrict__ cw, bf16_t* __restrict__ ACT, int nrows, int bid, int G, int tid) {
    const int gt = bid * NTHR + tid, NT = G * NTHR, total = (nrows / 64) * 2 * (FF / 4);
    for (int idx = gt; idx < total; idx += NT) {
        const int hrow = idx / (FF / 4), f = (idx % (FF / 4)) * 4, blk = hrow >> 1, last = hrow & 1, row = blk * 64 + (last ? 63 : 0);
        int t, len; if (row < ML) { t = row & (SEQ - 1); len = SEQ; } else { t = (row - ML) & (CTXL - 1); len = CTXL; }
        f32x4 ca = *(const f32x4*)(HP + (size_t)hrow * 2 * FF + f), cbv = *(const f32x4*)(HP + (size_t)hrow * 2 * FF + FF + f);
        if (!last && t > 0) { const size_t h = (size_t)(hrow - 1) * 2 * FF + f; ca += *(const f32x4*)(cw + f) * *(const f32x4*)(HU + h); cbv += *(const f32x4*)(cw + FF + f) * *(const f32x4*)(HU + h + FF); }
        if (last && t < len - 1) { const size_t h = (size_t)(hrow + 1) * 2 * FF + f; ca += *(const f32x4*)(cw + 2 * FF2 + f) * *(const f32x4*)(HU + h); cbv += *(const f32x4*)(cw + 2 * FF2 + FF + f) * *(const f32x4*)(HU + h + FF); }
        u32x2 w; w.x = pk2(silu_f(ca[0]) * cbv[0], silu_f(ca[1]) * cbv[1]); w.y = pk2(silu_f(ca[2]) * cbv[2], silu_f(ca[3]) * cbv[3]);
        *(u32x2*)(ACT + (size_t)row * FF + f) = w;
    }
}
__device__ __forceinline__ void phase_qknorm(const bf16_t* QKV, const float* qn, const float* kn, const float* cosa, const float* sina, bf16_t* Qn, bf16_t* Kn, bf16_t* Vn, int bid, int G, int wave, int lane) {
    const int gw = bid * NWAVES + wave, NGW = G * NWAVES;
    for (int it = gw; it < MT * 6; it += NGW) {
        const int row = it / 6, sg = it % 6, s = sg * 4 + (lane >> 4), i = lane & 15, d0 = 8 * i;
        float x[8]; unpack8(*(const bf16x8*)(QKV + (size_t)row * NAIN + s * 128 + d0), x);
        float ss = 0.f;
#pragma unroll
        for (int j = 0; j < 8; ++j) ss += x[j] * x[j];
        ss += __shfl_xor(ss, 1); ss += __shfl_xor(ss, 2); ss += __shfl_xor(ss, 4); ss += __shfl_xor(ss, 8);
        const bool latent = row < ML;
        if (s < 20) {
            const float rstd = 1.0f / sqrtf(ss * (1.f / 128.f) + EPS); const float* nw = (s < 16 ? qn : kn) + d0;
#pragma unroll
            for (int j = 0; j < 8; ++j) x[j] = x[j] * rstd * nw[j];
            if (latent) { const int t = row & (SEQ - 1); const f32x4 cs = *(const f32x4*)(cosa + t * 64 + 4 * i), sn = *(const f32x4*)(sina + t * 64 + 4 * i);
#pragma unroll
                for (int p = 0; p < 4; ++p) { const float x1 = x[2 * p], x2 = x[2 * p + 1]; x[2 * p] = x1 * cs[p] - x2 * sn[p]; x[2 * p + 1] = x1 * sn[p] + x2 * cs[p]; } }
        }
        const u32x4 o = pack8f(x);
        if (s < 16) { if (latent) *(u32x4*)(Qn + (size_t)row * DM + s * 128 + d0) = o; }
        else { const int b = latent ? (row >> 11) : ((row - ML) >> 8), key = latent ? CTXL + (row & (SEQ - 1)) : ((row - ML) & (CTXL - 1));
            bf16_t* dst = (s < 20 ? Kn : Vn) + ((size_t)b * SKV + key) * 512 + (s & 3) * 128 + d0; *(u32x4*)dst = o; }
    }
}
__device__ __forceinline__ void phase_attention(const bf16_t* Qn, const bf16_t* Kn, const bf16_t* Vn, bf16_t* O, unsigned char* lds_generic, int bid, int G, int tid) {
    for (int u = bid; u < 512; u += G) {
        const int grp = (u & 7) * 2 + (u >> 8), slot = (u >> 3) & 31, b = grp >> 2, kvh = grp & 3, h = kvh * 4 + (slot >> 3), qb = slot & 7;
        const size_t qoff = ((size_t)b * SEQ + qb * 256) * DM + h * 128, koff = (size_t)b * SKV * 512 + kvh * 128;
        att::attn_dense_body((const att::bf16*)(Qn + qoff), (const att::bf16*)(Kn + koff), (const att::bf16*)(Vn + koff), (att::bf16*)(O + qoff), SKV, (char*)lds_generic, tid);
        __syncthreads();
    }
}

#define XB_TMO      128
#define XB_XCNT(j)  (256  + 64 * (j))
#define XB_XSUB(j)  (1280 + 64 * (j))
#define XB_XGEN(j)  (2304 + 64 * (j))
#define XB_TOP      3328
#define XB_TOPGEN   3392
#define XCD_BAR_WORDS 3456
#define XB_XSUB(j)  (1280 + 64 * (j))
#define XB_XGEN(j)  (2304 + 64 * (j))
#define XB_TOP      3328
#define XB_TOPGEN   3392
#define XCD_BAR_WORDS 3456
#define XB_SPIN_CAP (1u << 18)

__device__ __forceinline__ unsigned xb_ld(unsigned* p)              { return __hip_atomic_load(p, __ATOMIC_RELAXED, __HIP_MEMORY_SCOPE_AGENT); }
__device__ __forceinline__ unsigned xb_add(unsigned* p, unsigned v) { return __hip_atomic_fetch_add(p, v, __ATOMIC_RELAXED, __HIP_MEMORY_SCOPE_AGENT); }
__device__ __forceinline__ unsigned xb_xcc_id() { return (unsigned)__builtin_amdgcn_s_getreg((3 << 11) | 20) & 0xFu; }
#define XB_SPIN(cond, bar) do { unsigned _sp = 0; while (cond) { __builtin_amdgcn_s_sleep(1); \
    if ((++_sp & 255u) == 0u) { if (xb_ld(&(bar)[XB_TMO])) break; if (_sp > XB_SPIN_CAP) { atomicAdd(&(bar)[XB_TMO], 1u); break; } } } } while (0)

struct XcdBarrier {
    unsigned* bar; unsigned x;
    volatile LAS unsigned* st;
};

__device__ __forceinline__ XcdBarrier xcd_barrier_post(unsigned* bar, volatile LAS unsigned* st) {
    XcdBarrier b; b.bar = bar; b.x = xb_xcc_id(); b.st = st;
    if (threadIdx.x == 0) (void)xb_add(&bar[XB_XCNT(b.x)], 1u);
    return b;
}
__device__ __forceinline__ void xcd_barrier_complete(unsigned* bar, unsigned x, unsigned& nloc, unsigned& nx) {
    const unsigned G = gridDim.x * gridDim.y * gridDim.z;
    unsigned sum, cnt, mine, sp = 0u;
    for (;;) {
        sum = 0u; cnt = 0u; mine = 0u;
#pragma unroll
        for (unsigned j = 0; j < 16; ++j) { const unsigned c = xb_ld(&bar[XB_XCNT(j)]); sum += c; cnt += (c > 0u) ? 1u : 0u; mine = (j == x) ? c : mine; }
        if (sum == G) break;
        __builtin_amdgcn_s_sleep(1);
        if ((++sp & 255u) == 0u) { if (xb_ld(&bar[XB_TMO])) break; if (sp > XB_SPIN_CAP) { atomicAdd(&bar[XB_TMO], 1u); break; } }
    }
    nloc = mine > 0u ? mine : 1u; nx = cnt > 0u ? cnt : 1u;
}

__device__ __forceinline__ void xcd_barrier(const XcdBarrier& b) {
    asm volatile("s_waitcnt vmcnt(0)" ::: "memory");
    __syncthreads();
    if (threadIdx.x == 0) {
        unsigned* bar = b.bar;
        __builtin_amdgcn_s_waitcnt(0);
        unsigned nloc = b.st[0], nx = b.st[1];
        if (nloc == 0u) { xcd_barrier_complete(bar, b.x, nloc, nx); b.st[0] = nloc; b.st[1] = nx; }
        const unsigned old = xb_add(&bar[XB_XSUB(b.x)], 1u);
        const unsigned gen = old / nloc;
        if (old + 1u == (gen + 1u) * nloc) {
            __builtin_amdgcn_fence(__ATOMIC_RELEASE, "agent");
            asm volatile("s_waitcnt vmcnt(0)" ::: "memory");
            const unsigned og = xb_add(&bar[XB_TOP], 1u);
            const unsigned tg = og / nx;
            if (og + 1u == (tg + 1u) * nx) xb_add(&bar[XB_TOPGEN], 1u);
            else XB_SPIN(xb_ld(&bar[XB_TOPGEN]) == tg, bar);
            __builtin_amdgcn_fence(__ATOMIC_ACQUIRE, "agent");
            xb_add(&bar[XB_XGEN(b.x)], 1u);
            asm volatile("s_waitcnt vmcnt(0)" ::: "memory");
        } else {
            XB_SPIN(xb_ld(&bar[XB_XGEN(b.x)]) == gen, bar);
            __builtin_amdgcn_fence(__ATOMIC_ACQUIRE, "agent");
            asm volatile("s_waitcnt vmcnt(0)" ::: "memory");
        }
    }
    __syncthreads();
}

__global__ void __launch_bounds__(NTHR, 2) mega(Args a) {
    extern __shared__ __attribute__((aligned(16))) unsigned char lds_raw[];
    LAS unsigned char* lds = (LAS unsigned char*)lds_raw;
    cg::grid_group grid = cg::this_grid();
    const int bid = blockIdx.x, G = gridDim.x;
    unsigned char* ws = a.ws;
    const float* MOD = (const float*)(ws + WS_MOD);
    float* XS = (float*)(ws + WS_XS); bf16_t* H = (bf16_t*)(ws + WS_H);
    unsigned char* R1 = ws + WS_R1; unsigned char* R2 = ws + WS_R2;
    volatile LAS unsigned* bst = (volatile LAS unsigned*)(lds + BAR_LDS_OFF);
    if (threadIdx.x < 2) bst[threadIdx.x] = 0u;
    __syncthreads();
    XcdBarrier xbar; xbar.bar = (unsigned*)(ws + WS_CTL); xbar.x = 0; xbar.st = nullptr;
    if (a.ph_hi - a.ph_lo > 1) xbar = xcd_barrier_post((unsigned*)(ws + WS_CTL), bst);
    auto run = [&](auto PC) {
        constexpr int p = decltype(PC)::value;
        int tid = threadIdx.x; asm volatile("" : "+v"(tid));
        const int lane = tid & 63, wave = __builtin_amdgcn_readfirstlane(tid >> 6);
        const int layer = p >= 10 ? 1 : 0;
        const float* mod = MOD + (size_t)layer * 5 * 12288;
        switch (PHSEL(p)) {
        case 0: phase_prologue(a, ws, lds, bid, G, tid, wave, lane); break;
        case 1: phase_norm(a.in[I_X], a.in[I_CTX], a.in[I_NORMW] + 0 * DM, mod, 0, H, MT, nullptr, XS, bid, G, wave, lane); break;
        case 6: phase_norm(XS, a.in[I_CTX], a.in[I_NORMW] + 1 * DM, mod, 3 * DM, H, MT, (const float*)R1, XS, bid, G, wave, lane); break;
        case 10: phase_norm(XS, XS + (size_t)ML * DM, a.in[I_NORMW] + 2 * DM, mod, 0, H, MT, (const float*)R1, XS, bid, G, wave, lane); break;
        case 15: phase_norm(XS, XS + (size_t)ML * DM, a.in[I_NORMW] + 3 * DM, mod, 3 * DM, H, ML, nullptr, XS, bid, G, wave, lane); break;
        case 2: {
            pg8::Gemm g{H, (const bf16_t*)(ws + WS_WRIN), MT, NRIN, DM}; pg8::StaticOrder S; S.init(MT, NRIN, DM, G, bid);
            pg8::EpiRow8<pg8::FRope> E{{(bf16_t*)(R1 + R1_Q), (bf16_t*)(R1 + R1_K), (bf16_t*)(R1 + R1_V), (bf16_t*)(R1 + R1_G), (const float*)(ws + WS_ROPER), (const float*)(ws + WS_ROPER) + 2048 * 128, ML}};
            pg8::gemm_phase<pg8::EpiRow8<pg8::FRope>, pg8::StaticOrder, true, true>(lds, g, S, E, tid);
            { const int rem = S.nwg % G; convert_jobs(1, a, ws, lds, rem ? (bid >= rem ? bid - rem : -1) : bid, rem ? G - rem : G, wave, lane); }
        } break;
        case 3: phase_retention((const bf16_t*)(R1 + R1_Q), (const bf16_t*)(R1 + R1_K), (const bf16_t*)(R1 + R1_V), (bf16_t*)R2, a.in[I_RLD], lds, bid, G, tid, wave, lane); break;
        case 4: phase_combine((const bf16_t*)R2, (const bf16_t*)(R1 + R1_G), a.in[I_RGN], (bf16_t*)(R1 + R1_V), bid, G, wave, lane); break;
        case 5: case 9: case 14: case 18: {
            const bf16_t* A; const bf16_t* Bt; int M, K; const float* bx; const float* bc; int goff;
            if (p == 5)       { A = (const bf16_t*)(R1 + R1_V); Bt = (const bf16_t*)(ws + WS_WROUT); M = MT; K = 2 * DM; bx = a.in[I_X]; bc = a.in[I_CTX]; goff = 2 * DM; }
            else if (p == 9)  { A = (const bf16_t*)R2; Bt = (const bf16_t*)(ws + WS_WDN); M = MT; K = FF; bx = XS; bc = XS + (size_t)ML * DM; goff = 5 * DM; }
            else if (p == 14) { A = (const bf16_t*)(R1 + R1_O); Bt = (const bf16_t*)(ws + WS_WAOUT); M = ML; K = DM; bx = XS; bc = XS + (size_t)ML * DM; goff = 2 * DM; }
            else              { A = (const bf16_t*)R2; Bt = (const bf16_t*)(ws + WS_WDN) + (size_t)DM * FF; M = ML; K = FF; bx = XS; bc = XS + (size_t)ML * DM; goff = 5 * DM; }
            pg8::Gemm g{A, Bt, M, DM, K};
            pg8::EpiRow8<pg8::FRes> E{{bx, bc, XS, mod + goff, ML, (float*)R1}};
            if constexpr (p == 5 || p == 9) { pg8::SplitOrder S; S.init(K, G, bid); pg8::gemm_phase<pg8::EpiRow8<pg8::FRes>, pg8::SplitOrder, true, true>(lds, g, S, E, tid); }
            else { pg8::StaticOrder S; S.init(M, DM, K, G, bid); pg8::gemm_phase<pg8::EpiRow8<pg8::FRes>, pg8::StaticOrder, true, true>(lds, g, S, E, tid); }
        } break;
        case 11: {
            pg8::Gemm g{H, (const bf16_t*)(ws + WS_WAIN), MT, NAIN, DM}; pg8::StaticOrder S; S.init(MT, NAIN, DM, G, bid);
            pg8::EpiRow8<pg8::FPlain> E{{(bf16_t*)R2, NAIN}};
            pg8::gemm_phase<pg8::EpiRow8<pg8::FPlain>, pg8::StaticOrder, true, true>(lds, g, S, E, tid);
        } break;
        case 7: case 16: {
            const int M = p == 7 ? MT : ML;
            pg8::Gemm g{H, (const bf16_t*)(ws + WS_WUP) + (p == 7 ? 0 : (size_t)FF2 * DM), M, FF2, DM}; pg8::StaticOrder S; S.init(M, FF2, DM, G, bid);
            pg8::EpiConv E{(bf16_t*)R2, a.in[I_FCW] + (p == 7 ? 0 : 3 * FF2), a.in[I_FCB] + (p == 7 ? 0 : FF2), (float*)(R1 + R1_HP), (float*)(R1 + R1_HU), FF};
            pg8::gemm_phase<pg8::EpiConv, pg8::StaticOrder, true, true>(lds, g, S, E, tid);
            if constexpr (p == 7) { const int rem = S.nwg % G; convert_jobs(2, a, ws, lds, rem ? (bid >= rem ? bid - rem : -1) : bid, rem ? G - rem : G, wave, lane); }
        } break;
        case 8: phase_conv_fix((const float*)(R1 + R1_HP), (const float*)(R1 + R1_HU), a.in[I_FCW], (bf16_t*)R2, MT, bid, G, tid); break;
        case 17: phase_conv_fix((const float*)(R1 + R1_HP), (const float*)(R1 + R1_HU), a.in[I_FCW] + 3 * FF2, (bf16_t*)R2, ML, bid, G, tid); break;
        case 12: phase_qknorm((const bf16_t*)R2, a.in[I_AQN], a.in[I_AKN], (const float*)(ws + WS_ROPEA), (const float*)(ws + WS_ROPEA) + 2048 * 64,
                              (bf16_t*)(R1 + R1_QN), (bf16_t*)(R1 + R1_KN), (bf16_t*)(R1 + R1_VN), bid, G, wave, lane); break;
        case 13: phase_attention((const bf16_t*)(R1 + R1_QN), (const bf16_t*)(R1 + R1_KN), (const bf16_t*)(R1 + R1_VN), (bf16_t*)(R1 + R1_O), lds_raw, bid, G, tid); break;
        case 19: phase_final(XS, a.in[I_FNW], a.out, bid, G, wave, lane); break;
        default: break;
        }
    };
    unsigned long long tp0 = 0, tp1 = 0;
#define RUNP(P) if (a.ph_lo <= (P) && (P) < a.ph_hi) { if ((P) == TIME_PHASE) tp0 = __builtin_amdgcn_s_memrealtime(); run(std::integral_constant<int, (P)>{}); if ((P) + 1 < a.ph_hi) { if (USE_CG_SYNC) grid.sync(); else xcd_barrier(xbar); } if ((P) == TIME_PHASE) tp1 = __builtin_amdgcn_s_memrealtime(); }
    if (TIME_PHASE == 99) tp0 = __builtin_amdgcn_s_memrealtime();
    RUNP(0) RUNP(1) RUNP(2) RUNP(3) RUNP(4) RUNP(5) RUNP(6) RUNP(7) RUNP(8) RUNP(9) RUNP(10) RUNP(11) RUNP(12) RUNP(13) RUNP(14) RUNP(15) RUNP(16) RUNP(17) RUNP(18) RUNP(19)
#undef RUNP
    if (TIME_PHASE == 99) tp1 = __builtin_amdgcn_s_memrealtime();
    if (TIME_PHASE >= 0 && bid == 0 && threadIdx.x == 0) { const unsigned long long tgt = (tp1 - tp0) * TIME_SCALE, ts = __builtin_amdgcn_s_memrealtime(); while (__builtin_amdgcn_s_memrealtime() - ts < tgt) __builtin_amdgcn_s_sleep(32); }
}

extern "C" void kernel_launch(void* const* d_in, const int* in_sizes, int n_in, void* d_out, int out_size, void* d_ws, size_t ws_size, hipStream_t stream) {
    static int grid = 0;
    if (grid == 0) {
        if (n_in != 20 || out_size != ML * DM || ws_size < WS_END) { fprintf(stderr, "kernel_launch: unexpected shapes: n_in %d out %d ws %zu (need %zu)\n", n_in, out_size, ws_size, (size_t)WS_END); grid = -1; return; }
        int dev = 0, cus = 0, per_cu = 0;
        hipGetDevice(&dev); hipDeviceGetAttribute(&cus, hipDeviceAttributeMultiprocessorCount, dev);
        if (hipFuncSetAttribute((const void*)mega, hipFuncAttributeMaxDynamicSharedMemorySize, LDS_BYTES) != hipSuccess) { fprintf(stderr, "kernel_launch: hipFuncSetAttribute failed\n"); grid = -1; return; }
        hipOccupancyMaxActiveBlocksPerMultiprocessor(&per_cu, (const void*)mega, NTHR, LDS_BYTES);
        if (per_cu < 1) { fprintf(stderr, "kernel_launch: occupancy query says %d blocks per CU\n", per_cu); per_cu = 1; }
        (void)hipGetLastError();
        grid = cus * 1;
        fprintf(stderr, "kernel_launch: grid %d (cus %d, per_cu %d), ws %zu need %zu\n", grid, cus, per_cu, ws_size, (size_t)WS_END);
    }
    if (grid < 0) return;
    Args a{};
    for (int i = 0; i < 20; ++i) a.in[i] = (const float*)d_in[i];
    a.out = (float*)d_out; a.ws = (unsigned char*)d_ws;
    if (hipMemsetAsync((char*)d_ws + WS_CTL, 0, WS_ROPER, stream) != hipSuccess) { fprintf(stderr, "kernel_launch: memset failed\n"); return; }
#if ONE_LAUNCH
    a.ph_lo = 0; a.ph_hi = NPH;
    void* args[] = {&a};
    hipError_t e = hipLaunchCooperativeKernel((const void*)mega, dim3(grid), dim3(NTHR), args, LDS_BYTES, stream);
    if (e != hipSuccess) fprintf(stderr, "kernel_launch: cooperative launch failed: %s (grid %d)\n", hipGetErrorString(e), grid);
#else
    for (int p = 0; p < NPH; ++p) { a.ph_lo = p; a.ph_hi = p + 1; hipLaunchKernelGGL(mega, dim3(grid), dim3(NTHR), LDS_BYTES, stream, a); }
    const hipError_t le = hipPeekAtLastError();
    if (le != hipSuccess) fprintf(stderr, "kernel_launch: launch failed: %s\n", hipGetErrorName(le));
#endif
}
```
